# Optimizing an MI355X kernel written in HIP

```python
import math
import jax, jax.numpy as jnp
from jax import lax
import numpy as np

D_MODEL = 1024
BATCH = 4
SEQ = 4096
DEPTH = 4
DEC_BATCH = 128
DEC_SEQ = 4
PAST_LEN = 8192
PAGE_SIZE = 128

MIX_WIDTH = D_MODEL
WIDTH_A = MIX_WIDTH // 2
HEAD_DIM_A = 128
N_HEADS_A = WIDTH_A // HEAD_DIM_A
CONV_WIDTH = 4
CONV_CH = 3 * WIDTH_A
CHUNK = 64
WIDTH_B = MIX_WIDTH - WIDTH_A
HEAD_DIM_B = 64
N_Q_HEADS_B = WIDTH_B // HEAD_DIM_B
N_KV_HEADS_B = 2
GQA_GROUP = N_Q_HEADS_B // N_KV_HEADS_B
KV_WIDTH_B = N_KV_HEADS_B * HEAD_DIM_B
WINDOW = 128
D_FF = 4 * D_MODEL
N_MOD = 6
IN_COLS = CONV_CH + WIDTH_A + 2 * N_HEADS_A + WIDTH_B + 2 * KV_WIDTH_B
EPS = 1e-6

kernel_name = 'hymba_gdn_swa_sink_decoder'


def rmsnorm(x, w):
    xf = x.astype(jnp.float32)
    y = xf * lax.rsqrt(jnp.mean(xf * xf, axis=-1, keepdims=True) + EPS)
    return (y * w.astype(jnp.float32)).astype(x.dtype)


def l2norm(x):
    return x * lax.rsqrt(jnp.sum(x * x, axis=-1, keepdims=True) + EPS)


def gated_delta_rule(q, k, v, beta, g, s0, chunk):
    b, t, h, dk = q.shape
    dv = v.shape[-1]
    n = t // chunk

    def blk(a):
        a = a.reshape((b, n, chunk, h) + a.shape[3:])
        return jnp.moveaxis(a, 3, 1)

    q, k, v, beta, g = blk(q), blk(k), blk(v), blk(beta), blk(g)
    gc = jnp.cumsum(g, axis=-1)
    idx = jnp.arange(chunk)
    lower = idx[:, None] >= idx[None, :]
    strict = idx[:, None] > idx[None, :]
    decay = jnp.exp(jnp.where(lower, gc[..., :, None] - gc[..., None, :], -jnp.inf))
    kb = k * beta[..., None]
    lmat = jnp.where(strict, jnp.einsum('bhnid,bhnjd->bhnij', kb, k) * decay, 0.0)
    amat = lmat + jnp.eye(chunk, dtype=lmat.dtype)
    rhs = jnp.concatenate([v * beta[..., None], kb * jnp.exp(gc)[..., None]], axis=-1)
    sol = lax.linalg.triangular_solve(amat, rhs, left_side=True, lower=True, unit_diagonal=True)
    u, w = sol[..., :dv], sol[..., dv:]
    attn = jnp.einsum('bhnid,bhnjd->bhnij', q, k) * decay
    qg = q * jnp.exp(gc)[..., None]
    kg = k * jnp.exp(gc[..., -1:] - gc)[..., None]
    g_last = jnp.exp(gc[..., -1])

    def step(s, xs):
        qg_n, kg_n, u_n, w_n, attn_n, gl_n = xs
        v_new = u_n - jnp.einsum('bhck,bhkv->bhcv', w_n, s)
        o = jnp.einsum('bhck,bhkv->bhcv', qg_n, s) + jnp.einsum('bhij,bhjv->bhiv', attn_n, v_new)
        s = s * gl_n[..., None, None] + jnp.einsum('bhck,bhcv->bhkv', kg_n, v_new)
        return s, o

    xs = tuple(jnp.moveaxis(a, 2, 0) for a in (qg, kg, u, w, attn, g_last))
    s_fin, o = lax.scan(step, s0, xs)
    o = jnp.moveaxis(jnp.moveaxis(o, 0, 2), 1, 3).reshape(b, t, h, dv)
    return o, s_fin


def sink_attention(q, k, v, sinks, mask):
    s = jnp.einsum('...qhgd,...khd->...hgqk', q, k).astype(jnp.float32) * (HEAD_DIM_B ** -0.5)
    s = jnp.where(mask, s, -jnp.inf)
    sk = sinks.astype(jnp.float32)[..., None, None]
    m = jnp.maximum(jnp.max(s, axis=-1, keepdims=True), sk)
    p = jnp.exp(s - m)
    p = (p / (jnp.sum(p, axis=-1, keepdims=True) + jnp.exp(sk - m))).astype(v.dtype)
    return jnp.einsum('...hgqk,...khd->...qhgd', p, v)


def swa_prompt(q, k, v, sinks):
    b, t = q.shape[:2]
    nb = t // WINDOW
    qb = q.reshape(b, nb, WINDOW, N_KV_HEADS_B, GQA_GROUP, HEAD_DIM_B)
    kb = k.reshape(b, nb, WINDOW, N_KV_HEADS_B, HEAD_DIM_B)
    vb = v.reshape(b, nb, WINDOW, N_KV_HEADS_B, HEAD_DIM_B)

    def with_prev(a):
        prev = jnp.concatenate([jnp.zeros_like(a[:, :1]), a[:, :-1]], axis=1)
        return jnp.concatenate([prev, a], axis=2)

    kc, vc = with_prev(kb), with_prev(vb)
    qi = jnp.arange(WINDOW)[:, None]
    kj = jnp.arange(2 * WINDOW)[None, :]
    band = (kj > qi) & (kj <= qi + WINDOW)
    real = (jnp.arange(nb)[:, None, None] > 0) | (kj[None] >= WINDOW)
    mask = (band[None] & real)[:, None, None]
    o = sink_attention(qb, kc, vc, sinks, mask)
    return o.reshape(b, t, WIDTH_B), k[:, -WINDOW:], v[:, -WINDOW:]


def swa_sample(q, k, v, kbuf, vbuf, sinks):
    b, t = q.shape[:2]
    kc = jnp.concatenate([kbuf.astype(k.dtype), k], axis=1)
    vc = jnp.concatenate([vbuf.astype(v.dtype), v], axis=1)
    qi = jnp.arange(t)[:, None]
    kj = jnp.arange(WINDOW + t)[None, :]
    mask = (kj > qi) & (kj <= qi + WINDOW)
    o = sink_attention(q, kc, vc, sinks, mask)
    return o.reshape(b, t, WIDTH_B), kc[:, -WINDOW:], vc[:, -WINDOW:]


def trunk_layer(x, c, conv_buf, ssm0, kbuf, vbuf,
                g_pre_mix, g_post_mix, g_pre_ffn, g_post_ffn, w_ada, b_ada,
                w_in, conv_w, a_log, dt_bias, gdn_norm_w, sinks, w_o, w_up, w_down):
    prompt = conv_buf is None
    b, t, _ = x.shape
    dt = x.dtype
    f32 = jnp.float32
    mod = (jax.nn.silu(c) @ w_ada + b_ada).reshape(b, 1, N_MOD, D_MODEL)
    shift_m, scale_m, gate_m = mod[:, :, 0], mod[:, :, 1], mod[:, :, 2]
    shift_f, scale_f, gate_f = mod[:, :, 3], mod[:, :, 4], mod[:, :, 5]

    h = rmsnorm(x, g_pre_mix) * (1 + scale_m) + shift_m
    proj = h @ w_in
    o1 = CONV_CH
    o2 = o1 + WIDTH_A
    o3 = o2 + N_HEADS_A
    o4 = o3 + N_HEADS_A
    o5 = o4 + WIDTH_B
    o6 = o5 + KV_WIDTH_B
    xc, z, b_lg, a_lg, q_b, k_b, v_b = jnp.split(proj, [o1, o2, o3, o4, o5, o6], axis=-1)

    if prompt:
        xp = jnp.concatenate([jnp.zeros((b, CONV_WIDTH - 1, CONV_CH), dt), xc], axis=1)
    else:
        xp = jnp.concatenate([conv_buf.astype(dt), xc], axis=1)
    new_conv = xp[:, -(CONV_WIDTH - 1):]
    xconv = jax.nn.silu(sum(xp[:, i:i + t] * conv_w[i] for i in range(CONV_WIDTH)))
    qa, ka, va = jnp.split(xconv, 3, axis=-1)
    qa = l2norm(qa.reshape(b, t, N_HEADS_A, HEAD_DIM_A).astype(f32)) * (HEAD_DIM_A ** -0.5)
    ka = l2norm(ka.reshape(b, t, N_HEADS_A, HEAD_DIM_A).astype(f32))
    va = va.reshape(b, t, N_HEADS_A, HEAD_DIM_A).astype(f32)
    beta = jax.nn.sigmoid(b_lg.astype(f32))
    g = -jnp.exp(a_log.astype(f32)) * jax.nn.softplus(a_lg.astype(f32) + dt_bias.astype(f32))
    if prompt:
        s0 = jnp.zeros((b, N_HEADS_A, HEAD_DIM_A, HEAD_DIM_A), f32)
        chunk = min(CHUNK, t)
    else:
        s0 = ssm0.astype(f32)
        chunk = t
    o_a, new_ssm = gated_delta_rule(qa, ka, va, beta, g, s0, chunk)
    o_a = rmsnorm(o_a, gdn_norm_w) * jax.nn.silu(z.reshape(b, t, N_HEADS_A, HEAD_DIM_A).astype(f32))
    o_a = o_a.astype(dt).reshape(b, t, WIDTH_A)

    q_b = q_b.reshape(b, t, N_KV_HEADS_B, GQA_GROUP, HEAD_DIM_B)
    k_b = k_b.reshape(b, t, N_KV_HEADS_B, HEAD_DIM_B)
    v_b = v_b.reshape(b, t, N_KV_HEADS_B, HEAD_DIM_B)
    sk = sinks.reshape(N_KV_HEADS_B, GQA_GROUP)
    if prompt:
        o_b, new_k, new_v = swa_prompt(q_b, k_b, v_b, sk)
    else:
        o_b, new_k, new_v = swa_sample(q_b, k_b, v_b, kbuf, vbuf, sk)

    mix = jnp.concatenate([o_a, o_b], axis=-1) @ w_o
    x = x + gate_m * rmsnorm(mix, g_post_mix)

    h = rmsnorm(x, g_pre_ffn) * (1 + scale_f) + shift_f
    y = jnp.square(jax.nn.relu(h @ w_up)) @ w_down
    x = x + gate_f * rmsnorm(y, g_post_ffn)
    return x, new_conv, new_ssm.astype(dt), new_k, new_v


def setup_inputs(seed: int = 0) -> dict:
    key = jax.random.key(seed)
    ks = jax.random.split(key, 24)
    f32 = jnp.float32

    def nrm(k, shape, scale=1.0):
        return jax.random.normal(k, shape, f32) * scale

    def gain(k, shape):
        return 1.0 + 0.05 * jax.random.normal(k, shape, f32)

    dt0 = jnp.exp(jax.random.uniform(ks[17], (DEPTH, N_HEADS_A), f32, math.log(1e-3), math.log(1e-1)))
    return {
        'x_prompt': nrm(ks[0], (BATCH, SEQ, D_MODEL)),
        'x_sample': nrm(ks[1], (DEC_BATCH, DEC_SEQ, D_MODEL)),
        'state_conv': nrm(ks[2], (DEPTH, DEC_BATCH, CONV_WIDTH - 1, CONV_CH)),
        'state_ssm': nrm(ks[3], (DEPTH, DEC_BATCH, N_HEADS_A, HEAD_DIM_A, HEAD_DIM_A), 0.1),
        'cache_swa_k': nrm(ks[4], (DEPTH, DEC_BATCH, WINDOW, N_KV_HEADS_B, HEAD_DIM_B)),
        'cache_swa_v': nrm(ks[5], (DEPTH, DEC_BATCH, WINDOW, N_KV_HEADS_B, HEAD_DIM_B)),
        'c_prompt': nrm(ks[6], (BATCH, D_MODEL)),
        'c_sample': nrm(ks[7], (DEC_BATCH, D_MODEL)),
        'g_pre_mix': gain(ks[8], (DEPTH, D_MODEL)),
        'g_post_mix': gain(ks[9], (DEPTH, D_MODEL)),
        'g_pre_ffn': gain(ks[10], (DEPTH, D_MODEL)),
        'g_post_ffn': gain(ks[11], (DEPTH, D_MODEL)),
        'w_ada': nrm(ks[12], (DEPTH, D_MODEL, N_MOD * D_MODEL), D_MODEL ** -0.5),
        'b_ada': nrm(ks[13], (DEPTH, N_MOD * D_MODEL), 0.01),
        'w_in': nrm(ks[14], (DEPTH, D_MODEL, IN_COLS), D_MODEL ** -0.5),
        'conv_w': nrm(ks[15], (DEPTH, CONV_WIDTH, CONV_CH), CONV_WIDTH ** -0.5),
        'a_log': jnp.log(jax.random.uniform(ks[16], (DEPTH, N_HEADS_A), f32, 1.0, 16.0)),
        'dt_bias': dt0 + jnp.log(-jnp.expm1(-dt0)),
        'gdn_norm_w': gain(ks[18], (DEPTH, HEAD_DIM_A)),
        'sinks': nrm(ks[19], (DEPTH, N_Q_HEADS_B), 0.5),
        'w_o': nrm(ks[20], (DEPTH, MIX_WIDTH, D_MODEL), MIX_WIDTH ** -0.5),
        'w_up': nrm(ks[21], (DEPTH, D_MODEL, D_FF), D_MODEL ** -0.5),
        'w_down': nrm(ks[22], (DEPTH, D_FF, D_MODEL), D_FF ** -0.5),
    }


def reference(x_prompt, x_sample, state_conv, state_ssm, cache_swa_k, cache_swa_v, c_prompt, c_sample,
              g_pre_mix, g_post_mix, g_pre_ffn, g_post_ffn, w_ada, b_ada, w_in, conv_w, a_log, dt_bias,
              gdn_norm_w, sinks, w_o, w_up, w_down):
    yp, ys = x_prompt, x_sample
    pc, ps, pk, pv = [], [], [], []
    sc, ss, skk, svv = [], [], [], []
    for l in range(DEPTH):
        lp = (g_pre_mix[l], g_post_mix[l], g_pre_ffn[l], g_post_ffn[l], w_ada[l], b_ada[l],
              w_in[l], conv_w[l], a_log[l], dt_bias[l], gdn_norm_w[l], sinks[l], w_o[l], w_up[l], w_down[l])
        yp, c1, s1, k1, v1 = trunk_layer(yp, c_prompt, None, None, None, None, *lp)
        ys, c2, s2, k2, v2 = trunk_layer(ys, c_sample, state_conv[l], state_ssm[l],
                                         cache_swa_k[l], cache_swa_v[l], *lp)
        pc.append(c1); ps.append(s1); pk.append(k1); pv.append(v1)
        sc.append(c2); ss.append(s2); skk.append(k2); svv.append(v2)
    return (yp, ys, jnp.stack(pc), jnp.stack(ps), jnp.stack(pk), jnp.stack(pv),
            jnp.stack(sc), jnp.stack(ss), jnp.stack(skk), jnp.stack(svv))
```

```cpp
#include <hip/hip_runtime.h>
#include <hip/hip_cooperative_groups.h>
#include <cstdio>
#include <cstdint>
#include <cmath>
namespace pg8 {
#define PG8_LAS __attribute__((address_space(3)))
typedef unsigned short bf16_t;
typedef short bf16x8 __attribute__((ext_vector_type(8)));
typedef float f32x4 __attribute__((ext_vector_type(4)));
typedef unsigned u32x4 __attribute__((ext_vector_type(4)));
constexpr int BM = 256, BK = 64, HALF = 128, HTB = HALF * BK * 2  , STAGE_BYTES = 8 * HTB, NXCD = 8, WGM = 8;

__host__ __device__ __forceinline__ int lds_byte(int r, int c) { const int st = (r >> 4) * 2 + (c >> 5), rr = r & 15, cc = c & 31, ob = rr * 64 + cc * 2; return st * 1024 + (ob ^ (((ob >> 9) & 1) << 5)); }
__host__ __device__ __forceinline__ void stage_rc(int b, int& R, int& C) { const int st = b / 1024, sb = b % 1024, swz = sb ^ (((sb >> 9) & 1) << 5); R = (st >> 1) * 16 + swz / 64; C = (st & 1) * 32 + (swz % 64) / 2; }
__host__ __device__ __forceinline__ int perm32(int rho) { const int n = rho >> 4, i = rho & 15; return 8 * (i >> 2) + 4 * n + (i & 3); }

struct Unit { int pm, pn; };
struct Gemm { const bf16_t* A; const bf16_t* Bt; int M, N, K; };

struct StaticOrder {
    int nM, nN, nwg, G, c;
    __host__ __device__ void init(int M, int N, int G_, int c_) { nM = M / BM; nN = N / BM; nwg = nM * nN; G = G_; c = c_; }
    __host__ __device__ bool next(int i, Unit& u) const {
        const long L = (long)i * G + c; if (L >= nwg) return false;
        int wgid = (int)L; { const int q = nwg / NXCD, r = nwg % NXCD, xcd = wgid % NXCD, off = wgid / NXCD; wgid = (xcd < r ? xcd * (q + 1) : r * (q + 1) + (xcd - r) * q) + off; }
        const int nig = WGM * nN, gid = wgid / nig, fm = gid * WGM, gsz = (nM - fm) < WGM ? (nM - fm) : WGM;
        u.pm = fm + ((wgid % nig) % gsz); u.pn = (wgid % nig) / gsz; return true;
    }
    __device__ __forceinline__ void a_ready(const Unit&) const {}
    __device__ __forceinline__ void done(const Unit&) const {}
};


__device__ __forceinline__ unsigned cvt_pk_bf16(float lo, float hi) { unsigned r; asm volatile("v_cvt_pk_bf16_f32 %0, %1, %2" : "=v"(r) : "v"(lo), "v"(hi)); return r; }
struct EpiF32 {
    static constexpr bool PERM = false, AFTER_DRAIN = false;
    float* C; int ldc; const float* bias;
    __device__ __forceinline__ void operator()(const f32x4 (&acc)[2][2][4][2], const Unit& u, int wr, int wc, int fr, int fq) const {
        const int row0 = u.pm * BM + wr * 64 + fr, col0 = u.pn * BM + wc * 32 + 4 * fq;
        f32x4 bv[2][2];
#pragma unroll
        for (int bj = 0; bj < 2; ++bj)
#pragma unroll
            for (int n = 0; n < 2; ++n) bv[bj][n] = bias ? *(const f32x4*)(bias + col0 + bj * HALF + n * 16) : (f32x4){0.f, 0.f, 0.f, 0.f};
#pragma unroll
        for (int ai = 0; ai < 2; ++ai)
#pragma unroll
            for (int m = 0; m < 4; ++m) { float* rowp = C + (size_t)(row0 + ai * HALF + m * 16) * ldc + col0;
#pragma unroll
                for (int bj = 0; bj < 2; ++bj)
#pragma unroll
                    for (int n = 0; n < 2; ++n) *(f32x4*)(rowp + bj * HALF + n * 16) = acc[ai][bj][m][n] + bv[bj][n]; }
    }
};
template <int ACT  > struct EpiBf16 {
    static constexpr bool PERM = true, AFTER_DRAIN = false;
    bf16_t* O; int ldc;
    __device__ __forceinline__ void operator()(const f32x4 (&acc)[2][2][4][2], const Unit& u, int wr, int wc, int fr, int fq) const {
        const int row0 = u.pm * BM + wr * 64 + fr; const int col0 = u.pn * BM + wc * 32 + 8 * fq;
#pragma unroll
        for (int ai = 0; ai < 2; ++ai)
#pragma unroll
            for (int m = 0; m < 4; ++m) { bf16_t* rowp = O + (size_t)(row0 + ai * HALF + m * 16) * ldc + col0;
#pragma unroll
                for (int bj = 0; bj < 2; ++bj) { f32x4 v0 = acc[ai][bj][m][0], v1 = acc[ai][bj][m][1];
                    if (ACT == 2) {
#pragma unroll
                        for (int e = 0; e < 4; ++e) { const float a = fmaxf(v0[e], 0.f), b = fmaxf(v1[e], 0.f); v0[e] = a * a; v1[e] = b * b; } }
                    u32x4 w; w.x = cvt_pk_bf16(v0[0], v0[1]); w.y = cvt_pk_bf16(v0[2], v0[3]); w.z = cvt_pk_bf16(v1[0], v1[1]); w.w = cvt_pk_bf16(v1[2], v1[3]);
                    *(u32x4*)(rowp + bj * HALF) = w; } }
    }
};

template <class Epi, class Sched, bool ALIGN_EPI = false, bool SP2 = false>
__device__ __forceinline__ void gemm_phase(PG8_LAS unsigned char* lds, const Gemm g, const Sched& S, const Epi& E, const int tid) {
    const int wid = __builtin_amdgcn_readfirstlane(tid >> 6), lane = tid & 63, wr = wid >> 2, wc = wid & 3, fr = lane & 15, fq = lane >> 4;
    const int K = g.K, nt = K / BK;
    unsigned voffA[2], voffB[2];
#pragma unroll
    for (int i = 0; i < 2; ++i) { int R, C; stage_rc(tid * 16 + i * 8192, R, C); const int Rb = Epi::PERM ? ((R & ~31) + perm32(R & 31)) : R;
        voffA[i] = (unsigned)(R * K + C) * 2u; voffB[i] = (unsigned)(Rb * K + C) * 2u; }
    const size_t kstep = (size_t)(BK * 2);
    const size_t hstep = (size_t)HALF * K * 2;
    const size_t tstep = 2 * hstep;
    const unsigned ldsw = (unsigned)wid * 1024u;
    const int aoff = lds_byte(wr * 64 + fr, fq * 8), boff = lds_byte(wc * 32 + fr, fq * 8);
#define PG8_SA(b, h) (((b) * 2 + (h)) * HTB)
#define PG8_SB(b, h) ((4 + (b) * 2 + (h)) * HTB)
#define PG8_STAGE(bufoff, gbase, voff) do { _Pragma("unroll") for (int _i = 0; _i < 2; ++_i) \
        __builtin_amdgcn_global_load_lds((const unsigned*)((const char*)(gbase) + (voff)[_i]), (PG8_LAS unsigned*)(lds + (bufoff) + ldsw + _i * 8192), 16, 0, 0); } while (0)
#define PG8_LDA(dst, b, h) do { _Pragma("unroll") for (int m = 0; m < 4; ++m) _Pragma("unroll") for (int k = 0; k < 2; ++k) dst[m][k] = *(const PG8_LAS bf16x8*)(lds + PG8_SA(b, h) + aoff + m * 2048 + k * 1024); } while (0)
#define PG8_LDB(dst, b, h) do { _Pragma("unroll") for (int n = 0; n < 2; ++n) _Pragma("unroll") for (int k = 0; k < 2; ++k) dst[n][k] = *(const PG8_LAS bf16x8*)(lds + PG8_SB(b, h) + boff + n * 2048 + k * 1024); } while (0)
#define PG8_MMA(ai, bj, At, Bt) do { __builtin_amdgcn_s_setprio(1); _Pragma("unroll") for (int m = 0; m < 4; ++m) _Pragma("unroll") for (int n = 0; n < 2; ++n) _Pragma("unroll") for (int k = 0; k < 2; ++k) \
        acc[ai][bj][m][n] = __builtin_amdgcn_mfma_f32_16x16x32_bf16(Bt[n][k], At[m][k], acc[ai][bj][m][n], 0, 0, 0); __builtin_amdgcn_s_setprio(0); } while (0)
#define PG8_WAIT_V(n) asm volatile("s_waitcnt vmcnt(" #n ")" ::: "memory")
#define PG8_WAIT_L(n) asm volatile("s_waitcnt lgkmcnt(" #n ")" ::: "memory")
#define PG8_BAR __builtin_amdgcn_s_barrier()
#define PG8_SCHED __builtin_amdgcn_sched_barrier(0)
    Unit cur, nxt; int ui = 0;
    if (!S.next(0, cur)) return;
    f32x4 acc[2][2][4][2];
#pragma unroll
    for (int a = 0; a < 2; ++a)
#pragma unroll
        for (int b = 0; b < 2; ++b)
#pragma unroll
            for (int m = 0; m < 4; ++m)
#pragma unroll
                for (int n = 0; n < 2; ++n) acc[a][b][m][n] = (f32x4){0.f, 0.f, 0.f, 0.f};
    bf16x8 At[4][2], B0[2][2], B1[2][2];
    const char* cA = (const char*)g.A + (size_t)cur.pm * tstep; const char* cB = (const char*)g.Bt + (size_t)cur.pn * tstep;
    S.a_ready(cur);
    if constexpr (SP2) {
        PG8_STAGE(PG8_SB(0, 0), cB, voffB); PG8_STAGE(PG8_SB(0, 1), cB + hstep, voffB); PG8_STAGE(PG8_SA(0, 0), cA, voffA); PG8_STAGE(PG8_SA(0, 1), cA + hstep, voffA);
        if (wr == 1) PG8_BAR;
        PG8_WAIT_V(2); PG8_BAR;
        PG8_STAGE(PG8_SB(1, 0), cB + kstep, voffB); PG8_STAGE(PG8_SA(1, 0), cA + kstep, voffA); PG8_STAGE(PG8_SB(1, 1), cB + hstep + kstep, voffB);
        PG8_WAIT_V(6); PG8_BAR;
    } else {
        PG8_STAGE(PG8_SB(0, 0), cB, voffB); PG8_STAGE(PG8_SA(0, 0), cA, voffA); PG8_STAGE(PG8_SB(0, 1), cB + hstep, voffB); PG8_STAGE(PG8_SA(0, 1), cA + hstep, voffA);
        if (wr == 1) PG8_BAR;
        PG8_WAIT_V(4); PG8_BAR;
        PG8_STAGE(PG8_SB(1, 0), cB + kstep, voffB); PG8_STAGE(PG8_SA(1, 0), cA + kstep, voffA); PG8_STAGE(PG8_SB(1, 1), cB + hstep + kstep, voffB);
        PG8_WAIT_V(6); PG8_BAR;
    }
    for (;;) {
        const bool has_next = S.next(ui + 1, nxt);
        const char* nA = has_next ? (const char*)g.A + (size_t)nxt.pm * tstep : cA; const char* nB = has_next ? (const char*)g.Bt + (size_t)nxt.pn * tstep : cB;
        for (int t = 0; t < nt; t += 2) {
            const bool last = (t == nt - 2);
            const char* a1 = cA + (size_t)(t + 1) * kstep;
            const char* a2 = last ? nA : cA + (size_t)(t + 2) * kstep; const char* b2 = last ? nB : cB + (size_t)(t + 2) * kstep;
            const char* a3 = a2 + kstep; const char* b3 = b2 + kstep;
            if (last && has_next) S.a_ready(nxt);
            if constexpr (SP2) {
            PG8_LDB(B0, 0, 0); PG8_LDB(B1, 0, 1); PG8_SCHED; PG8_LDA(At, 0, 0); PG8_STAGE(PG8_SA(1, 1), a1 + hstep, voffA);
            PG8_WAIT_V(8); PG8_WAIT_L(0); PG8_BAR; PG8_MMA(0, 0, At, B0); PG8_MMA(0, 1, At, B1); PG8_BAR; PG8_SCHED;
            PG8_LDA(At, 0, 1); PG8_STAGE(PG8_SB(0, 0), b2, voffB); PG8_STAGE(PG8_SB(0, 1), b2 + hstep, voffB); PG8_STAGE(PG8_SA(0, 0), a2, voffA);
            PG8_WAIT_V(8); PG8_WAIT_L(0); PG8_BAR; PG8_MMA(1, 0, At, B0); PG8_MMA(1, 1, At, B1); PG8_BAR; PG8_SCHED;
            PG8_LDB(B0, 1, 0); PG8_LDB(B1, 1, 1); PG8_SCHED; PG8_LDA(At, 1, 0); PG8_STAGE(PG8_SA(0, 1), a2 + hstep, voffA);
            PG8_WAIT_V(8); PG8_WAIT_L(0); PG8_BAR; PG8_MMA(0, 0, At, B0); PG8_MMA(0, 1, At, B1); PG8_BAR; PG8_SCHED;
            PG8_LDA(At, 1, 1); PG8_STAGE(PG8_SB(1, 0), b3, voffB); PG8_STAGE(PG8_SB(1, 1), b3 + hstep, voffB); PG8_STAGE(PG8_SA(1, 0), a3, voffA);
            PG8_WAIT_V(8); PG8_WAIT_L(0); PG8_BAR; PG8_MMA(1, 0, At, B0); PG8_MMA(1, 1, At, B1); PG8_BAR; PG8_SCHED;
            } else {
            PG8_LDB(B0, 0, 0); PG8_SCHED; PG8_LDA(At, 0, 0); PG8_STAGE(PG8_SA(1, 1), a1 + hstep, voffA);
            PG8_WAIT_L(8); PG8_BAR; PG8_WAIT_L(0); PG8_MMA(0, 0, At, B0); PG8_BAR; PG8_SCHED;
            PG8_LDB(B1, 0, 1); PG8_STAGE(PG8_SB(0, 0), b2, voffB);
            PG8_BAR; PG8_WAIT_L(0); PG8_MMA(0, 1, At, B1); PG8_BAR;
            PG8_LDA(At, 0, 1); PG8_STAGE(PG8_SA(0, 0), a2, voffA);
            PG8_BAR; PG8_WAIT_L(0); PG8_MMA(1, 0, At, B0); PG8_BAR; PG8_SCHED;
            PG8_STAGE(PG8_SB(0, 1), b2 + hstep, voffB);
            PG8_WAIT_V(6); PG8_BAR; PG8_MMA(1, 1, At, B1); PG8_BAR;
            PG8_LDB(B0, 1, 0); PG8_SCHED; PG8_LDA(At, 1, 0); PG8_STAGE(PG8_SA(0, 1), a2 + hstep, voffA);
            PG8_WAIT_L(8); PG8_BAR; PG8_WAIT_L(0); PG8_MMA(0, 0, At, B0); PG8_BAR; PG8_SCHED;
            PG8_LDB(B1, 1, 1); PG8_STAGE(PG8_SB(1, 0), b3, voffB);
            PG8_BAR; PG8_WAIT_L(0); PG8_MMA(0, 1, At, B1); PG8_BAR;
            PG8_LDA(At, 1, 1); PG8_STAGE(PG8_SA(1, 0), a3, voffA);
            PG8_BAR; PG8_WAIT_L(0); PG8_MMA(1, 0, At, B0); PG8_BAR; PG8_SCHED;
            PG8_STAGE(PG8_SB(1, 1), b3 + hstep, voffB);
            PG8_WAIT_V(6); PG8_BAR; PG8_MMA(1, 1, At, B1); PG8_BAR;
            }
        }
        if constexpr (ALIGN_EPI) { if (wr == 0) PG8_BAR; }
        if constexpr (!Epi::AFTER_DRAIN) { E(acc, cur, wr, wc, fr, fq); S.done(cur); }
        if (!has_next) break;
#pragma unroll
        for (int a = 0; a < 2; ++a)
#pragma unroll
            for (int b = 0; b < 2; ++b)
#pragma unroll
                for (int m = 0; m < 4; ++m)
#pragma unroll
                    for (int n = 0; n < 2; ++n) acc[a][b][m][n] = (f32x4){0.f, 0.f, 0.f, 0.f};
        cur = nxt; cA = nA; cB = nB; ++ui;
        if constexpr (ALIGN_EPI) { if (wr == 1) PG8_BAR; }
    }
    PG8_WAIT_V(0);
    if constexpr (!ALIGN_EPI) { if (wr == 0) PG8_BAR; }
    PG8_BAR;
    if constexpr (Epi::AFTER_DRAIN) { E.fused(acc, cur, wr, wc, fr, fq, lds, wid, lane); S.done(cur); }
#undef PG8_SA
#undef PG8_SB
#undef PG8_STAGE
#undef PG8_LDA
#undef PG8_LDB
#undef PG8_MMA
#undef PG8_WAIT_V
#undef PG8_WAIT_L
#undef PG8_BAR
#undef PG8_SCHED
}
}

#ifndef PG8_SP2
#define PG8_SP2 true
#endif
#ifndef PG8_ALIGN
#define PG8_ALIGN true
#endif
#ifndef MK_ONE_LAUNCH
#define MK_ONE_LAUNCH 0
#endif

constexpr int NWAVES = 8, NTHR = NWAVES * 64;
constexpr int D = 1024, DEPTH = 4, SEQ = 4096, NB_P = 4, NB_S = 128, T_S = 4;
constexpr int MP = NB_P * SEQ, MS = NB_S * T_S, M = MP + MS;
constexpr int NPROJ = 3072, NPROJ_REAL = 2824, FF = 4096, NMOD = 6 * D, CONVCH = 1536;
constexpr int PC_QA = 0, PC_KA = 512, PC_VA = 1024, PC_Z = 1536, PC_QB = 2048, PC_KB = 2560, PC_VB = 2688, PC_BLG = 2816, PC_ALG = 2820;
constexpr float EPS = 1e-6f;
constexpr size_t OY_P = 0, OY_S = OY_P + (size_t)MP * D, OCONV_P = OY_S + (size_t)MS * D, OSSM_P = OCONV_P + (size_t)DEPTH * NB_P * 3 * CONVCH,
    OK_P = OSSM_P + (size_t)DEPTH * NB_P * 4 * 128 * 128, OV_P = OK_P + (size_t)DEPTH * NB_P * 128 * 128, OCONV_S = OV_P + (size_t)DEPTH * NB_P * 128 * 128,
    OSSM_S = OCONV_S + (size_t)DEPTH * NB_S * 3 * CONVCH, OK_S = OSSM_S + (size_t)DEPTH * NB_S * 4 * 128 * 128, OV_S = OK_S + (size_t)DEPTH * NB_S * 128 * 128,
    OUT_TOTAL = OV_S + (size_t)DEPTH * NB_S * 128 * 128;
static_assert(OUT_TOTAL == 71639040, "output size");

constexpr size_t MiB = 1u << 20;
constexpr size_t WS_CTL = 0, CTL_ZERO_BYTES = 1 * MiB;
constexpr size_t WS_WIN = 1 * MiB, WS_WO = 25 * MiB, WS_WUP = 33 * MiB, WS_WDN = 65 * MiB;
constexpr size_t WS_SC = 97 * MiB;
constexpr size_t WS_MOD = 98 * MiB;
constexpr size_t WS_X = 122 * MiB;
constexpr size_t WS_XN = 188 * MiB;
constexpr size_t WS_PROJ = 221 * MiB;
constexpr size_t WS_O = 320 * MiB;
constexpr size_t WS_H = 221 * MiB;
constexpr size_t WS_MIX = 353 * MiB;
constexpr size_t WS_WADA = 419 * MiB;
constexpr size_t WS_END = 467 * MiB;
static_assert(WS_PROJ + (size_t)M * NPROJ * 2 <= WS_O && WS_O + (size_t)M * D * 2 <= WS_MIX && WS_H + (size_t)M * FF * 2 <= WS_MIX && WS_MIX + (size_t)M * D * 4 <= WS_WADA, "ws map");
static_assert(WS_X + (size_t)M * D * 4 <= WS_XN && WS_XN + (size_t)M * D * 2 <= WS_PROJ && WS_MOD + (size_t)256 * 24576 * 4 <= WS_X, "ws map 2");
constexpr int CW_BAR = 4096;

constexpr int RING_OFF = 0, RING_BYTES = 131072;
constexpr int LDSCTL_OFF = RING_BYTES, MISC_OFF = LDSCTL_OFF + 320;
constexpr int LDS_BYTES = 147456;

#define GAS __attribute__((address_space(1)))
#define LAS __attribute__((address_space(3)))
typedef unsigned short bf16;
typedef unsigned v4u __attribute__((ext_vector_type(4)));
typedef float f32x4 __attribute__((ext_vector_type(4)));
typedef GAS unsigned gu32;
#define LDS_WAIT() asm volatile("s_waitcnt lgkmcnt(0)" ::: "memory")
#define VM_WAIT() asm volatile("s_waitcnt vmcnt(0)" ::: "memory")
__device__ __forceinline__ unsigned f2bf(float f) { unsigned u = __builtin_bit_cast(unsigned, f); return (u + 0x7fffu + ((u >> 16) & 1u)) >> 16; }
__device__ __forceinline__ unsigned pk2(float lo, float hi) { return f2bf(lo) | (f2bf(hi) << 16); }
__device__ __forceinline__ float bf2f(bf16 h) { return __builtin_bit_cast(float, (unsigned)h << 16); }
__device__ __forceinline__ float bflo(unsigned w) { return __builtin_bit_cast(float, w << 16); }
__device__ __forceinline__ float bfhi(unsigned w) { return __builtin_bit_cast(float, w & 0xffff0000u); }
__device__ __forceinline__ float wave_sum(float v) {
#pragma unroll
    for (int o = 1; o < 64; o <<= 1) v += __shfl_xor(v, o);
    return v;
}
__device__ __forceinline__ float wave_max(float v) {
#pragma unroll
    for (int o = 1; o < 64; o <<= 1) v = fmaxf(v, __shfl_xor(v, o));
    return v;
}
__device__ __forceinline__ float siluf(float x) { return x / (1.f + __expf(-x)); }
__device__ __forceinline__ float sigmf(float x) { return 1.f / (1.f + __expf(-x)); }
__device__ __forceinline__ float softplusf(float x) { return x > 20.f ? x : log1pf(__expf(x)); }

struct Frame {
    LAS unsigned char* lds;
    int tid, lane, wave, G, bid;
    float* out; unsigned char* ws;
};
__device__ __forceinline__ unsigned char* wsp(const Frame& F) { unsigned char* p = F.ws; asm volatile("" : "+s"(p)); return p; }
constexpr int TAB_OFF = LDSCTL_OFF + 1024;
__device__ __forceinline__ const float* inp(const Frame& F, int i) {
    const unsigned long long v = ((const LAS unsigned long long*)(F.lds + TAB_OFF))[i];
    const unsigned lo = __builtin_amdgcn_readfirstlane((unsigned)v), hi = __builtin_amdgcn_readfirstlane((unsigned)(v >> 32));
    return (const float*)(((unsigned long long)hi << 32) | lo);
}
#define IN_XP 0
#define IN_XS 1
#define IN_SCONV 2
#define IN_SSSM 3
#define IN_CK 4
#define IN_CV 5
#define IN_CP 6
#define IN_CS 7
#define IN_GPREM 8
#define IN_GPOSTM 9
#define IN_GPREF 10
#define IN_GPOSTF 11
#define IN_WADA 12
#define IN_BADA 13
#define IN_WIN 14
#define IN_CONVW 15
#define IN_ALOG 16
#define IN_DTB 17
#define IN_GDNW 18
#define IN_SINKS 19
#define IN_WO 20
#define IN_WUP 21
#define IN_WDN 22

template <int MAPKIND  >
__device__ __forceinline__ void p0_transpose_item(const float* W, int K, int N, int Ndst, bf16* WT, LAS float* scr, int item, int lane) {
    const int nblk = Ndst / 32, kb = item / nblk, nb = item % nblk, k0 = 64 * kb, n0 = 32 * nb;
    const int nd = n0 + (lane & 31);
    int ns = nd;
    if (MAPKIND == 1) { ns = nd < 2048 ? nd : (nd < 2816 ? nd + 8 : (nd < 2824 ? nd - 768 : -1)); }
#pragma unroll 8
    for (int i = 0; i < 32; ++i) { const int kk = 2 * i + (lane >> 5); scr[kk * 33 + (lane & 31)] = (ns >= 0) ? W[(size_t)(k0 + kk) * N + ns] : 0.f; }
    LDS_WAIT(); asm volatile("" ::: "memory");
    const int c = lane & 7;
#pragma unroll
    for (int j = 0; j < 4; ++j) { const int n = (lane >> 3) + 8 * j; const LAS float* s = scr + (8 * c) * 33 + n;
        v4u o; o.x = pk2(s[0 * 33], s[1 * 33]); o.y = pk2(s[2 * 33], s[3 * 33]); o.z = pk2(s[4 * 33], s[5 * 33]); o.w = pk2(s[6 * 33], s[7 * 33]);
        *(GAS v4u*)(WT + (size_t)(n0 + n) * K + k0 + 8 * c) = o; }
    LDS_WAIT(); asm volatile("" ::: "memory");
}

__device__ __forceinline__ void p0_prologue(Frame& F) {
    LAS float* scr = (LAS float*)(F.lds + RING_OFF + F.wave * 16384);
    const int gw = F.bid * NWAVES + F.wave, NGW = F.G * NWAVES;
    constexpr int I_IN = (D / 64) * (NPROJ / 32), I_O = (D / 64) * (D / 32), I_UP = (D / 64) * (FF / 32), I_DN = (FF / 64) * (D / 32), I_ADA = (D / 64) * (NMOD / 32);
    constexpr int PER_L = I_IN + I_O + I_UP + I_DN + I_ADA;
    for (int it = gw; it < DEPTH * PER_L; it += NGW) {
        const int l = it / PER_L; int r = it % PER_L;
        if (r < I_IN) { p0_transpose_item<1>(inp(F, IN_WIN) + (size_t)l * D * NPROJ_REAL, D, NPROJ_REAL, NPROJ, (bf16*)(wsp(F) + WS_WIN) + (size_t)l * NPROJ * D, scr, r, F.lane); continue; } r -= I_IN;
        if (r < I_O) { p0_transpose_item<0>(inp(F, IN_WO) + (size_t)l * D * D, D, D, D, (bf16*)(wsp(F) + WS_WO) + (size_t)l * D * D, scr, r, F.lane); continue; } r -= I_O;
        if (r < I_UP) { p0_transpose_item<0>(inp(F, IN_WUP) + (size_t)l * D * FF, D, FF, FF, (bf16*)(wsp(F) + WS_WUP) + (size_t)l * FF * D, scr, r, F.lane); continue; } r -= I_UP;
        if (r < I_DN) { p0_transpose_item<0>(inp(F, IN_WDN) + (size_t)l * FF * D, FF, D, D, (bf16*)(wsp(F) + WS_WDN) + (size_t)l * D * FF, scr, r, F.lane); continue; } r -= I_DN;
        p0_transpose_item<0>(inp(F, IN_WADA) + (size_t)l * D * NMOD, D, NMOD, NMOD, (bf16*)(wsp(F) + WS_WADA) + (size_t)l * NMOD * D, scr, r, F.lane);
    }
    bf16* SC = (bf16*)(wsp(F) + WS_SC);
    for (int i = F.bid * NTHR + F.tid; i < 256 * D; i += F.G * NTHR) {
        const int r = i >> 10, c = i & 1023; float v = 0.f;
        if (r < NB_P) v = siluf(inp(F, IN_CP)[r * D + c]); else if (r < NB_P + NB_S) v = siluf(inp(F, IN_CS)[(r - NB_P) * D + c]);
        SC[i] = (bf16)f2bf(v);
    }
}

__device__ __forceinline__ const float* modp(Frame& F, int row, int l, int j) {
    const int mrow = row < MP ? (row >> 12) : NB_P + ((row - MP) >> 2);
    return (const float*)(wsp(F) + WS_MOD) + (size_t)mrow * (DEPTH * NMOD) + l * NMOD + j * D;
}
__device__ __forceinline__ void modnorm_store(Frame& F, const f32x4 (&v)[4], const float* g, const float* scale, const float* shift, bf16* orow) {
    float s = 0.f;
#pragma unroll
    for (int j = 0; j < 4; ++j) s += (v[j].x * v[j].x + v[j].y * v[j].y) + (v[j].z * v[j].z + v[j].w * v[j].w);
    const float rs = 1.0f / sqrtf(wave_sum(s) * (1.f / D) + EPS);
    GAS unsigned long long* o8 = (GAS unsigned long long*)orow + F.lane;
#pragma unroll
    for (int j = 0; j < 4; ++j) {
        const f32x4 gg = ((const f32x4*)g)[F.lane + 64 * j], sc = ((const f32x4*)scale)[F.lane + 64 * j], sh = ((const f32x4*)shift)[F.lane + 64 * j];
        const f32x4 h = (v[j] * rs) * gg * (sc + 1.0f) + sh;
        o8[64 * j] = (unsigned long long)pk2(h.x, h.y) | ((unsigned long long)pk2(h.z, h.w) << 32);
    }
}
__device__ __forceinline__ const float* xin_row(Frame& F, int row) { return row < MP ? inp(F, IN_XP) + (size_t)row * D : inp(F, IN_XS) + (size_t)(row - MP) * D; }
__device__ __forceinline__ void rowpass0(Frame& F) {
    const int gw = F.bid * NWAVES + F.wave, NGW = F.G * NWAVES;
    for (int row = gw; row < M; row += NGW) {
        const f32x4* xr = (const f32x4*)xin_row(F, row) + F.lane; f32x4 v[4];
#pragma unroll
        for (int j = 0; j < 4; ++j) v[j] = xr[64 * j];
        modnorm_store(F, v, inp(F, IN_GPREM), modp(F, row, 0, 1), modp(F, row, 0, 0), (bf16*)(wsp(F) + WS_XN) + (size_t)row * D);
    }
}
__device__ __forceinline__ void rowpass12(Frame& F, int l, int kind) {
    const int gw = F.bid * NWAVES + F.wave, NGW = F.G * NWAVES;
    float* X = (float*)(wsp(F) + WS_X); const float* MIX = (const float*)(wsp(F) + WS_MIX);
    for (int row = gw; row < M; row += NGW) {
        const float* xsrc = (l == 0 && kind == 1) ? xin_row(F, row) : X + (size_t)row * D;
        const f32x4* xr = (const f32x4*)xsrc + F.lane; const f32x4* mr = (const f32x4*)(MIX + (size_t)row * D) + F.lane;
        f32x4 x[4], m[4]; float s = 0.f;
#pragma unroll
        for (int j = 0; j < 4; ++j) { x[j] = xr[64 * j]; m[j] = mr[64 * j]; s += (m[j].x * m[j].x + m[j].y * m[j].y) + (m[j].z * m[j].z + m[j].w * m[j].w); }
        const float rs = 1.0f / sqrtf(wave_sum(s) * (1.f / D) + EPS);
        const float* gpost = inp(F, kind == 1 ? IN_GPOSTM : IN_GPOSTF) + l * D; const float* gate = modp(F, row, l, kind == 1 ? 2 : 5);
#pragma unroll
        for (int j = 0; j < 4; ++j) { const f32x4 gp = ((const f32x4*)gpost)[F.lane + 64 * j], gt = ((const f32x4*)gate)[F.lane + 64 * j]; x[j] = x[j] + gt * ((m[j] * rs) * gp); }
        const bool fin = (kind == 2 && l == DEPTH - 1);
        float* xdst = fin ? (row < MP ? F.out + OY_P + (size_t)row * D : F.out + OY_S + (size_t)(row - MP) * D) : X + (size_t)row * D;
#pragma unroll
        for (int j = 0; j < 4; ++j) ((f32x4*)xdst)[F.lane + 64 * j] = x[j];
        if (!fin) {
            if (kind == 1) modnorm_store(F, x, inp(F, IN_GPREF) + l * D, modp(F, row, l, 4), modp(F, row, l, 3), (bf16*)(wsp(F) + WS_XN) + (size_t)row * D);
            else modnorm_store(F, x, inp(F, IN_GPREM) + (l + 1) * D, modp(F, row, l + 1, 1), modp(F, row, l + 1, 0), (bf16*)(wsp(F) + WS_XN) + (size_t)row * D);
        }
    }
}

__device__ __forceinline__ void gdn_naive_item(Frame& F, int l, int row0, int T, int h, const float* S0, const float* cbuf, float* Sout, float* convout) {
    LAS float* sm = (LAS float*)(F.lds + RING_OFF);
    LAS float* red = sm + 384; LAS float* red2 = sm + 896; LAS float* part = sm + 1408; LAS float* part2 = sm + 1416; LAS float* scal = sm + 1424;
    const int tid = F.tid, v = tid & 127, kq = tid >> 7;
    const bf16* PROJ = (const bf16*)(wsp(F) + WS_PROJ); bf16* O = (bf16*)(wsp(F) + WS_O);
    float S[32];
#pragma unroll
    for (int i = 0; i < 32; ++i) S[i] = S0 ? S0[(kq * 32 + i) * 128 + v] : 0.f;
    float x1 = 0.f, x2 = 0.f, x3 = 0.f, cw0 = 0.f, cw1 = 0.f, cw2 = 0.f, cw3 = 0.f; int ch = 0;
    if (tid < 384) {
        ch = (tid >> 7) * 512 + h * 128 + (tid & 127);
        const float* cw = inp(F, IN_CONVW) + (size_t)l * 4 * CONVCH;
        cw0 = cw[ch]; cw1 = cw[CONVCH + ch]; cw2 = cw[2 * CONVCH + ch]; cw3 = cw[3 * CONVCH + ch];
        if (cbuf) { x1 = cbuf[ch]; x2 = cbuf[CONVCH + ch]; x3 = cbuf[2 * CONVCH + ch]; }
    }
    const float Aexp = __expf(inp(F, IN_ALOG)[l * 4 + h]), dtb = inp(F, IN_DTB)[l * 4 + h];
    const float gw = inp(F, IN_GDNW)[l * 128 + v];
    __syncthreads();
    for (int t = 0; t < T; ++t) {
        const size_t row = (size_t)(row0 + t); const bf16* prow = PROJ + row * NPROJ;
        if (tid < 384) {
            const float x = bf2f(prow[ch]);
            const float a = cw0 * x1 + cw1 * x2 + cw2 * x3 + cw3 * x; x1 = x2; x2 = x3; x3 = x;
            const float xc = siluf(a); sm[tid] = xc;
            const float ss = wave_sum(xc * xc); if (F.lane == 0) part[F.wave] = ss;
        }
        if (tid == 384) {
            const float bl = bf2f(prow[PC_BLG + h]), al = bf2f(prow[PC_ALG + h]);
            scal[0] = sigmf(bl); scal[1] = __expf(-Aexp * softplusf(al + dtb));
        }
        __syncthreads();
        const float rq = (1.0f / sqrtf(part[0] + part[1] + EPS)) * 0.08838834764831845f, rk = 1.0f / sqrtf(part[2] + part[3] + EPS);
        const float beta = scal[0], a = scal[1];
        float p = 0.f;
#pragma unroll
        for (int i = 0; i < 32; ++i) { S[i] *= a; p += S[i] * (sm[128 + kq * 32 + i] * rk); }
        red[kq * 128 + v] = p;
        __syncthreads();
        const float tot = (red[v] + red[128 + v]) + (red[256 + v] + red[384 + v]);
        const float coef = beta * (sm[256 + v] - tot);
        float op = 0.f;
#pragma unroll
        for (int i = 0; i < 32; ++i) { S[i] += (sm[128 + kq * 32 + i] * rk) * coef; op += S[i] * (sm[kq * 32 + i] * rq); }
        red2[kq * 128 + v] = op;
        __syncthreads();
        float o = 0.f;
        if (tid < 128) { o = (red2[v] + red2[128 + v]) + (red2[256 + v] + red2[384 + v]); const float ss = wave_sum(o * o); if (F.lane == 0) part2[F.wave] = ss; }
        __syncthreads();
        if (tid < 128) {
            const float rn = 1.0f / sqrtf((part2[0] + part2[1]) * (1.f / 128.f) + EPS);
            const float z = bf2f(prow[PC_Z + h * 128 + v]);
            O[row * D + h * 128 + v] = (bf16)f2bf(o * rn * gw * siluf(z));
        }
    }
#pragma unroll
    for (int i = 0; i < 32; ++i) Sout[(kq * 32 + i) * 128 + v] = S[i];
    if (tid < 384) { convout[ch] = x1; convout[CONVCH + ch] = x2; convout[2 * CONVCH + ch] = x3; }
    __syncthreads();
}

__device__ __forceinline__ void swa_naive_item(Frame& F, int l, int row, int kvh) {
    LAS float* scw = (LAS float*)(F.lds + RING_OFF + 8192 + F.wave * 2048);
    const bf16* PROJ = (const bf16*)(wsp(F) + WS_PROJ); bf16* O = (bf16*)(wsp(F) + WS_O);
    const int lane = F.lane;
    const bool samp = row >= MP;
    const int b = samp ? (row - MP) >> 2 : row >> 12, t = samp ? (row - MP) & 3 : row & 4095;
    const int seq0 = samp ? MP + b * 4 : b * SEQ;
    const bf16* prow = PROJ + (size_t)row * NPROJ;
    float qv[4];
#pragma unroll
    for (int g = 0; g < 4; ++g) qv[g] = bf2f(prow[PC_QB + (kvh * 4 + g) * 64 + lane]);
    const float* ck = inp(F, IN_CK) + ((size_t)(l * NB_S + b) * 128) * 128 + kvh * 64;
    const float* cv = inp(F, IN_CV) + ((size_t)(l * NB_S + b) * 128) * 128 + kvh * 64;
#pragma unroll 2
    for (int ci = 0; ci < 128; ++ci) {
        float kv; bool valid = true;
        if (!samp) { int s = t - 127 + ci; valid = s >= 0; s = valid ? s : 0; kv = bf2f(PROJ[(size_t)(seq0 + s) * NPROJ + PC_KB + kvh * 64 + lane]); }
        else { const int cidx = t + 1 + ci; kv = cidx < 128 ? ck[(size_t)cidx * 128 + lane] : bf2f(PROJ[(size_t)(seq0 + cidx - 128) * NPROJ + PC_KB + kvh * 64 + lane]); }
#pragma unroll
        for (int g = 0; g < 4; ++g) { const float s = wave_sum(qv[g] * kv); if (lane == 0) scw[g * 128 + ci] = valid ? s * 0.125f : -INFINITY; }
    }
    LDS_WAIT(); asm volatile("" ::: "memory");
#pragma unroll
    for (int g = 0; g < 4; ++g) {
        const float sk = inp(F, IN_SINKS)[l * 8 + kvh * 4 + g];
        const float s0 = scw[g * 128 + lane], s1 = scw[g * 128 + 64 + lane];
        const float mx = fmaxf(wave_max(fmaxf(s0, s1)), sk);
        const float p0 = __expf(s0 - mx), p1 = __expf(s1 - mx);
        const float den = wave_sum(p0 + p1) + __expf(sk - mx);
        scw[g * 128 + lane] = p0 / den; scw[g * 128 + 64 + lane] = p1 / den;
    }
    LDS_WAIT(); asm volatile("" ::: "memory");
    float o[4] = {0.f, 0.f, 0.f, 0.f};
#pragma unroll 2
    for (int ci = 0; ci < 128; ++ci) {
        float vv;
        if (!samp) { int s = t - 127 + ci; s = s < 0 ? 0 : s; vv = bf2f(PROJ[(size_t)(seq0 + s) * NPROJ + PC_VB + kvh * 64 + lane]); }
        else { const int cidx = t + 1 + ci; vv = cidx < 128 ? cv[(size_t)cidx * 128 + lane] : bf2f(PROJ[(size_t)(seq0 + cidx - 128) * NPROJ + PC_VB + kvh * 64 + lane]); }
#pragma unroll
        for (int g = 0; g < 4; ++g) o[g] += scw[g * 128 + ci] * vv;
    }
#pragma unroll
    for (int g = 0; g < 4; ++g) O[(size_t)row * D + 512 + (kvh * 4 + g) * 64 + lane] = (bf16)f2bf(o[g]);
    LDS_WAIT(); asm volatile("" ::: "memory");
}

__device__ __forceinline__ void mixers_naive(Frame& F, int l) {
    const bf16* PROJ = (const bf16*)(wsp(F) + WS_PROJ);
    if (F.bid < 16) {
        const int b = F.bid >> 2, h = F.bid & 3;
        gdn_naive_item(F, l, b * SEQ, SEQ, h, nullptr, nullptr, F.out + OSSM_P + ((size_t)(l * NB_P + b) * 4 + h) * 16384, F.out + OCONV_P + (size_t)(l * NB_P + b) * 3 * CONVCH);
        return;
    }
    const int wg = F.bid - 16, nwg = F.G - 16;
    for (int it = wg; it < NB_S * 4; it += nwg) {
        const int b = it >> 2, h = it & 3;
        gdn_naive_item(F, l, MP + b * T_S, T_S, h, inp(F, IN_SSSM) + ((size_t)(l * NB_S + b) * 4 + h) * 16384, inp(F, IN_SCONV) + (size_t)(l * NB_S + b) * 3 * CONVCH,
                       F.out + OSSM_S + ((size_t)(l * NB_S + b) * 4 + h) * 16384, F.out + OCONV_S + (size_t)(l * NB_S + b) * 3 * CONVCH);
    }
    for (int it = wg * NWAVES + F.wave; it < M * 2; it += nwg * NWAVES) swa_naive_item(F, l, it >> 1, it & 1);
    const int gt = wg * NTHR + F.tid, ngt = nwg * NTHR;
    for (int i = gt; i < NB_P * 128 * 128; i += ngt) {
        const int b = i >> 14, j = (i >> 7) & 127, c = i & 127; const bf16* prow = PROJ + (size_t)(b * SEQ + SEQ - 128 + j) * NPROJ;
        F.out[OK_P + (size_t)l * NB_P * 16384 + i] = bf2f(prow[PC_KB + c]); F.out[OV_P + (size_t)l * NB_P * 16384 + i] = bf2f(prow[PC_VB + c]);
    }
    for (int i = gt; i < NB_S * 128 * 128; i += ngt) {
        const int b = i >> 14, j = (i >> 7) & 127, c = i & 127; float kk, vv;
        if (j < 124) { const size_t src = ((size_t)(l * NB_S + b) * 128 + j + 4) * 128 + c; kk = inp(F, IN_CK)[src]; vv = inp(F, IN_CV)[src]; }
        else { const bf16* prow = PROJ + (size_t)(MP + b * T_S + (j - 124)) * NPROJ; kk = bf2f(prow[PC_KB + c]); vv = bf2f(prow[PC_VB + c]); }
        F.out[OK_S + (size_t)l * NB_S * 16384 + i] = kk; F.out[OV_S + (size_t)l * NB_S * 16384 + i] = vv;
    }
}

struct Args { const float* in[23]; float* out; unsigned char* ws; int ph_lo, ph_hi; };
constexpr int NPH = 3 + 7 * DEPTH;

__global__ void __launch_bounds__(NTHR, 2) mega_fwd(Args args) {
    extern __shared__ __attribute__((aligned(16))) unsigned char lds[];
    Frame F;
    F.lds = (LAS unsigned char*)lds;
    F.tid = threadIdx.x; F.lane = F.tid & 63; F.wave = __builtin_amdgcn_readfirstlane(F.tid >> 6);
    F.G = gridDim.x; F.bid = blockIdx.x;
    if (F.tid < 23) ((LAS unsigned long long*)(F.lds + TAB_OFF))[F.tid] = (unsigned long long)args.in[F.tid];
    F.out = args.out; F.ws = args.ws;
    __syncthreads();
#if MK_ONE_LAUNCH
    cooperative_groups::grid_group grid = cooperative_groups::this_grid();
#endif
    for (int ph = args.ph_lo; ph < args.ph_hi; ++ph) {
        { int t_ = threadIdx.x; asm volatile("" : "+v"(t_)); F.tid = t_; F.lane = t_ & 63; F.wave = __builtin_amdgcn_readfirstlane(t_ >> 6); }
        int kind, l = 0;
        if (ph < 3) kind = ph; else { l = (ph - 3) / 7; kind = 3 + (ph - 3) % 7; }
        if (kind == 0) p0_prologue(F);
        else if (kind == 2) rowpass0(F);
        else if (kind == 4) mixers_naive(F, l);
        else if (kind == 6) rowpass12(F, l, 1);
        else if (kind == 9) rowpass12(F, l, 2);
        else if (kind == 3) {
            pg8::Gemm g{(const bf16*)(wsp(F) + WS_XN), (const bf16*)(wsp(F) + WS_WIN) + (size_t)l * NPROJ * D, M, NPROJ, D};
            pg8::StaticOrder S; S.init(M, NPROJ, F.G, F.bid);
            pg8::EpiBf16<0> E{(bf16*)(wsp(F) + WS_PROJ), NPROJ};
            pg8::gemm_phase<pg8::EpiBf16<0>, pg8::StaticOrder, PG8_ALIGN, PG8_SP2>(F.lds + RING_OFF, g, S, E, F.tid);
        } else if (kind == 7) {
            pg8::Gemm g{(const bf16*)(wsp(F) + WS_XN), (const bf16*)(wsp(F) + WS_WUP) + (size_t)l * FF * D, M, FF, D};
            pg8::StaticOrder S; S.init(M, FF, F.G, F.bid);
            pg8::EpiBf16<2> E{(bf16*)(wsp(F) + WS_H), FF};
            pg8::gemm_phase<pg8::EpiBf16<2>, pg8::StaticOrder, PG8_ALIGN, PG8_SP2>(F.lds + RING_OFF, g, S, E, F.tid);
        } else {
            pg8::Gemm g; pg8::EpiF32 E;
            if (kind == 1) { g = pg8::Gemm{(const bf16*)(wsp(F) + WS_SC), (const bf16*)(wsp(F) + WS_WADA), 256, DEPTH * NMOD, D}; E = pg8::EpiF32{(float*)(wsp(F) + WS_MOD), DEPTH * NMOD, inp(F, IN_BADA)}; }
            else if (kind == 5) { g = pg8::Gemm{(const bf16*)(wsp(F) + WS_O), (const bf16*)(wsp(F) + WS_WO) + (size_t)l * D * D, M, D, D}; E = pg8::EpiF32{(float*)(wsp(F) + WS_MIX), D, nullptr}; }
            else { g = pg8::Gemm{(const bf16*)(wsp(F) + WS_H), (const bf16*)(wsp(F) + WS_WDN) + (size_t)l * D * FF, M, D, FF}; E = pg8::EpiF32{(float*)(wsp(F) + WS_MIX), D, nullptr}; }
            pg8::StaticOrder S; S.init(g.M, g.N, F.G, F.bid);
            pg8::gemm_phase<pg8::EpiF32, pg8::StaticOrder, PG8_ALIGN, PG8_SP2>(F.lds + RING_OFF, g, S, E, F.tid);
        }
#if MK_ONE_LAUNCH
        if (ph + 1 < args.ph_hi) grid.sync();
#endif
    }
}

extern "C" void kernel_launch(void* const* d_in, const int* in_sizes, int n_in, void* d_out, int out_size, void* d_ws, size_t ws_size, hipStream_t stream) {
    static int grid = 0;
    if (grid == 0) {
        if (n_in != 23 || (size_t)out_size != OUT_TOTAL || ws_size < WS_END) { fprintf(stderr, "kernel_launch: unexpected shapes n_in %d out %d ws %zu\n", n_in, out_size, ws_size); grid = -1; return; }
        int dev = 0, cus = 0, per_cu = 0;
        if (hipGetDevice(&dev) != hipSuccess || hipDeviceGetAttribute(&cus, hipDeviceAttributeMultiprocessorCount, dev) != hipSuccess) { grid = -1; return; }
        if (hipFuncSetAttribute((const void*)mega_fwd, hipFuncAttributeMaxDynamicSharedMemorySize, LDS_BYTES) != hipSuccess) { fprintf(stderr, "kernel_launch: hipFuncSetAttribute failed\n"); grid = -1; return; }
        if (hipOccupancyMaxActiveBlocksPerMultiprocessor(&per_cu, (const void*)mega_fwd, NTHR, LDS_BYTES) != hipSuccess || per_cu < 1) { fprintf(stderr, "kernel_launch: occupancy query says %d\n", per_cu); per_cu = 1; }
        (void)hipGetLastError();
        grid = cus;
    }
    if (grid < 0) return;
    Args a{};
    for (int i = 0; i < 23; ++i) a.in[i] = (const float*)d_in[i];
    a.out = (float*)d_out; a.ws = (unsigned char*)d_ws;
#if MK_ONE_LAUNCH
    a.ph_lo = 0; a.ph_hi = NPH;
    void* kargs[] = {&a};
    hipError_t e = hipLaunchCooperativeKernel((const void*)mega_fwd, dim3(grid), dim3(NTHR), kargs, LDS_BYTES, stream);
    if (e != hipSuccess) fprintf(stderr, "cooperative launch failed: %s (grid %d)\n", hipGetErrorString(e), grid);
#else
    for (int ph = 0; ph < NPH; ++ph) {
        a.ph_lo = ph; a.ph_hi = ph + 1;
        hipLaunchKernelGGL(mega_fwd, dim3(grid), dim3(NTHR), LDS_BYTES, stream, a);
    }
#endif
}
```

```cpp
#include <hip/hip_runtime.h>
#include <hip/hip_cooperative_groups.h>
#include <cstdio>
#include <cstdint>
#include <cmath>
namespace pg8 {
#define PG8_LAS __attribute__((address_space(3)))
typedef unsigned short bf16_t;
typedef short bf16x8 __attribute__((ext_vector_type(8)));
typedef float f32x4 __attribute__((ext_vector_type(4)));
typedef unsigned u32x4 __attribute__((ext_vector_type(4)));
constexpr int BM = 256, BK = 64, HALF = 128, HTB = HALF * BK * 2  , STAGE_BYTES = 8 * HTB, NXCD = 8, WGM = 8;

__host__ __device__ __forceinline__ int lds_byte(int r, int c) { const int st = (r >> 4) * 2 + (c >> 5), rr = r & 15, cc = c & 31, ob = rr * 64 + cc * 2; return st * 1024 + (ob ^ (((ob >> 9) & 1) << 5)); }
__host__ __device__ __forceinline__ void stage_rc(int b, int& R, int& C) { const int st = b / 1024, sb = b % 1024, swz = sb ^ (((sb >> 9) & 1) << 5); R = (st >> 1) * 16 + swz / 64; C = (st & 1) * 32 + (swz % 64) / 2; }
__host__ __device__ __forceinline__ int perm32(int rho) { const int n = rho >> 4, i = rho & 15; return 8 * (i >> 2) + 4 * n + (i & 3); }

struct Unit { int pm, pn; };
struct Gemm { const bf16_t* A; const bf16_t* Bt; int M, N, K; };

struct StaticOrder {
    int nM, nN, nwg, G, c;
    __host__ __device__ void init(int M, int N, int G_, int c_) { nM = M / BM; nN = N / BM; nwg = nM * nN; G = G_; c = c_; }
    __host__ __device__ bool next(int i, Unit& u) const {
        const long L = (long)i * G + c; if (L >= nwg) return false;
        int wgid = (int)L; { const int q = nwg / NXCD, r = nwg % NXCD, xcd = wgid % NXCD, off = wgid / NXCD; wgid = (xcd < r ? xcd * (q + 1) : r * (q + 1) + (xcd - r) * q) + off; }
        const int nig = WGM * nN, gid = wgid / nig, fm = gid * WGM, gsz = (nM - fm) < WGM ? (nM - fm) : WGM;
        u.pm = fm + ((wgid % nig) % gsz); u.pn = (wgid % nig) / gsz; return true;
    }
    __device__ __forceinline__ void a_ready(const Unit&) const {}
    __device__ __forceinline__ void done(const Unit&) const {}
};


__device__ __forceinline__ unsigned cvt_pk_bf16(float lo, float hi) { unsigned r; asm volatile("v_cvt_pk_bf16_f32 %0, %1, %2" : "=v"(r) : "v"(lo), "v"(hi)); return r; }
struct EpiF32 {
    static constexpr bool PERM = false, AFTER_DRAIN = false;
    float* C; int ldc; const float* bias;
    __device__ __forceinline__ void operator()(const f32x4 (&acc)[2][2][4][2], const Unit& u, int wr, int wc, int fr, int fq) const {
        const int row0 = u.pm * BM + wr * 64 + fr, col0 = u.pn * BM + wc * 32 + 4 * fq;
        f32x4 bv[2][2];
#pragma unroll
        for (int bj = 0; bj < 2; ++bj)
#pragma unroll
            for (int n = 0; n < 2; ++n) bv[bj][n] = bias ? *(const f32x4*)(bias + col0 + bj * HALF + n * 16) : (f32x4){0.f, 0.f, 0.f, 0.f};
#pragma unroll
        for (int ai = 0; ai < 2; ++ai)
#pragma unroll
            for (int m = 0; m < 4; ++m) { float* rowp = C + (size_t)(row0 + ai * HALF + m * 16) * ldc + col0;
#pragma unroll
                for (int bj = 0; bj < 2; ++bj)
#pragma unroll
                    for (int n = 0; n < 2; ++n) *(f32x4*)(rowp + bj * HALF + n * 16) = acc[ai][bj][m][n] + bv[bj][n]; }
    }
};
template <int ACT  > struct EpiBf16 {
    static constexpr bool PERM = true, AFTER_DRAIN = false;
    bf16_t* O; int ldc;
    __device__ __forceinline__ void operator()(const f32x4 (&acc)[2][2][4][2], const Unit& u, int wr, int wc, int fr, int fq) const {
        const int row0 = u.pm * BM + wr * 64 + fr; const int col0 = u.pn * BM + wc * 32 + 8 * fq;
#pragma unroll
        for (int ai = 0; ai < 2; ++ai)
#pragma unroll
            for (int m = 0; m < 4; ++m) { bf16_t* rowp = O + (size_t)(row0 + ai * HALF + m * 16) * ldc + col0;
#pragma unroll
                for (int bj = 0; bj < 2; ++bj) { f32x4 v0 = acc[ai][bj][m][0], v1 = acc[ai][bj][m][1];
                    if (ACT == 2) {
#pragma unroll
                        for (int e = 0; e < 4; ++e) { const float a = fmaxf(v0[e], 0.f), b = fmaxf(v1[e], 0.f); v0[e] = a * a; v1[e] = b * b; } }
                    u32x4 w; w.x = cvt_pk_bf16(v0[0], v0[1]); w.y = cvt_pk_bf16(v0[2], v0[3]); w.z = cvt_pk_bf16(v1[0], v1[1]); w.w = cvt_pk_bf16(v1[2], v1[3]);
                    *(u32x4*)(rowp + bj * HALF) = w; } }
    }
};

template <class Epi, class Sched, bool ALIGN_EPI = false, bool SP2 = false>
__device__ __forceinline__ void gemm_phase(PG8_LAS unsigned char* lds, const Gemm g, const Sched& S, const Epi& E, const int tid) {
    const int wid = __builtin_amdgcn_readfirstlane(tid >> 6), lane = tid & 63, wr = wid >> 2, wc = wid & 3, fr = lane & 15, fq = lane >> 4;
    const int K = g.K, nt = K / BK;
    unsigned voffA[2], voffB[2];
#pragma unroll
    for (int i = 0; i < 2; ++i) { int R, C; stage_rc(tid * 16 + i * 8192, R, C); const int Rb = Epi::PERM ? ((R & ~31) + perm32(R & 31)) : R;
        voffA[i] = (unsigned)(R * K + C) * 2u; voffB[i] = (unsigned)(Rb * K + C) * 2u; }
    const size_t kstep = (size_t)(BK * 2);
    const size_t hstep = (size_t)HALF * K * 2;
    const size_t tstep = 2 * hstep;
    const unsigned ldsw = (unsigned)wid * 1024u;
    const int aoff = lds_byte(wr * 64 + fr, fq * 8), boff = lds_byte(wc * 32 + fr, fq * 8);
#define PG8_SA(b, h) (((b) * 2 + (h)) * HTB)
#define PG8_SB(b, h) ((4 + (b) * 2 + (h)) * HTB)
#define PG8_STAGE(bufoff, gbase, voff) do { _Pragma("unroll") for (int _i = 0; _i < 2; ++_i) \
        __builtin_amdgcn_global_load_lds((const unsigned*)((const char*)(gbase) + (voff)[_i]), (PG8_LAS unsigned*)(lds + (bufoff) + ldsw + _i * 8192), 16, 0, 0); } while (0)
#define PG8_LDA(dst, b, h) do { _Pragma("unroll") for (int m = 0; m < 4; ++m) _Pragma("unroll") for (int k = 0; k < 2; ++k) dst[m][k] = *(const PG8_LAS bf16x8*)(lds + PG8_SA(b, h) + aoff + m * 2048 + k * 1024); } while (0)
#define PG8_LDB(dst, b, h) do { _Pragma("unroll") for (int n = 0; n < 2; ++n) _Pragma("unroll") for (int k = 0; k < 2; ++k) dst[n][k] = *(const PG8_LAS bf16x8*)(lds + PG8_SB(b, h) + boff + n * 2048 + k * 1024); } while (0)
#define PG8_MMA(ai, bj, At, Bt) do { __builtin_amdgcn_s_setprio(1); _Pragma("unroll") for (int m = 0; m < 4; ++m) _Pragma("unroll") for (int n = 0; n < 2; ++n) _Pragma("unroll") for (int k = 0; k < 2; ++k) \
        acc[ai][bj][m][n] = __builtin_amdgcn_mfma_f32_16x16x32_bf16(Bt[n][k], At[m][k], acc[ai][bj][m][n], 0, 0, 0); __builtin_amdgcn_s_setprio(0); } while (0)
#define PG8_WAIT_V(n) asm volatile("s_waitcnt vmcnt(" #n ")" ::: "memory")
#define PG8_WAIT_L(n) asm volatile("s_waitcnt lgkmcnt(" #n ")" ::: "memory")
#define PG8_BAR __builtin_amdgcn_s_barrier()
#define PG8_SCHED __builtin_amdgcn_sched_barrier(0)
    Unit cur, nxt; int ui = 0;
    if (!S.next(0, cur)) return;
    f32x4 acc[2][2][4][2];
#pragma unroll
    for (int a = 0; a < 2; ++a)
#pragma unroll
        for (int b = 0; b < 2; ++b)
#pragma unroll
            for (int m = 0; m < 4; ++m)
#pragma unroll
                for (int n = 0; n < 2; ++n) acc[a][b][m][n] = (f32x4){0.f, 0.f, 0.f, 0.f};
    bf16x8 At[4][2], B0[2][2], B1[2][2];
    const char* cA = (const char*)g.A + (size_t)cur.pm * tstep; const char* cB = (const char*)g.Bt + (size_t)cur.pn * tstep;
    S.a_ready(cur);
    if constexpr (SP2) {
        PG8_STAGE(PG8_SB(0, 0), cB, voffB); PG8_STAGE(PG8_SB(0, 1), cB + hstep, voffB); PG8_STAGE(PG8_SA(0, 0), cA, voffA); PG8_STAGE(PG8_SA(0, 1), cA + hstep, voffA);
        if (wr == 1) PG8_BAR;
        PG8_WAIT_V(2); PG8_BAR;
        PG8_STAGE(PG8_SB(1, 0), cB + kstep, voffB); PG8_STAGE(PG8_SA(1, 0), cA + kstep, voffA); PG8_STAGE(PG8_SB(1, 1), cB + hstep + kstep, voffB);
        PG8_WAIT_V(6); PG8_BAR;
    } else {
        PG8_STAGE(PG8_SB(0, 0), cB, voffB); PG8_STAGE(PG8_SA(0, 0), cA, voffA); PG8_STAGE(PG8_SB(0, 1), cB + hstep, voffB); PG8_STAGE(PG8_SA(0, 1), cA + hstep, voffA);
        if (wr == 1) PG8_BAR;
        PG8_WAIT_V(4); PG8_BAR;
        PG8_STAGE(PG8_SB(1, 0), cB + kstep, voffB); PG8_STAGE(PG8_SA(1, 0), cA + kstep, voffA); PG8_STAGE(PG8_SB(1, 1), cB + hstep + kstep, voffB);
        PG8_WAIT_V(6); PG8_BAR;
    }
    for (;;) {
        const bool has_next = S.next(ui + 1, nxt);
        const char* nA = has_next ? (const char*)g.A + (size_t)nxt.pm * tstep : cA; const char* nB = has_next ? (const char*)g.Bt + (size_t)nxt.pn * tstep : cB;
        for (int t = 0; t < nt; t += 2) {
            const bool last = (t == nt - 2);
            const char* a1 = cA + (size_t)(t + 1) * kstep;
            const char* a2 = last ? nA : cA + (size_t)(t + 2) * kstep; const char* b2 = last ? nB : cB + (size_t)(t + 2) * kstep;
            const char* a3 = a2 + kstep; const char* b3 = b2 + kstep;
            if (last && has_next) S.a_ready(nxt);
            if constexpr (SP2) {
            PG8_LDB(B0, 0, 0); PG8_LDB(B1, 0, 1); PG8_SCHED; PG8_LDA(At, 0, 0); PG8_STAGE(PG8_SA(1, 1), a1 + hstep, voffA);
            PG8_WAIT_V(8); PG8_WAIT_L(0); PG8_BAR; PG8_MMA(0, 0, At, B0); PG8_MMA(0, 1, At, B1); PG8_BAR; PG8_SCHED;
            PG8_LDA(At, 0, 1); PG8_STAGE(PG8_SB(0, 0), b2, voffB); PG8_STAGE(PG8_SB(0, 1), b2 + hstep, voffB); PG8_STAGE(PG8_SA(0, 0), a2, voffA);
            PG8_WAIT_V(8); PG8_WAIT_L(0); PG8_BAR; PG8_MMA(1, 0, At, B0); PG8_MMA(1, 1, At, B1); PG8_BAR; PG8_SCHED;
            PG8_LDB(B0, 1, 0); PG8_LDB(B1, 1, 1); PG8_SCHED; PG8_LDA(At, 1, 0); PG8_STAGE(PG8_SA(0, 1), a2 + hstep, voffA);
            PG8_WAIT_V(8); PG8_WAIT_L(0); PG8_BAR; PG8_MMA(0, 0, At, B0); PG8_MMA(0, 1, At, B1); PG8_BAR; PG8_SCHED;
            PG8_LDA(At, 1, 1); PG8_STAGE(PG8_SB(1, 0), b3, voffB); PG8_STAGE(PG8_SB(1, 1), b3 + hstep, voffB); PG8_STAGE(PG8_SA(1, 0), a3, voffA);
            PG8_WAIT_V(8); PG8_WAIT_L(0); PG8_BAR; PG8_MMA(1, 0, At, B0); PG8_MMA(1, 1, At, B1); PG8_BAR; PG8_SCHED;
            } else {
            PG8_LDB(B0, 0, 0); PG8_SCHED; PG8_LDA(At, 0, 0); PG8_STAGE(PG8_SA(1, 1), a1 + hstep, voffA);
            PG8_WAIT_L(8); PG8_BAR; PG8_WAIT_L(0); PG8_MMA(0, 0, At, B0); PG8_BAR; PG8_SCHED;
            PG8_LDB(B1, 0, 1); PG8_STAGE(PG8_SB(0, 0), b2, voffB);
            PG8_BAR; PG8_WAIT_L(0); PG8_MMA(0, 1, At, B1); PG8_BAR;
            PG8_LDA(At, 0, 1); PG8_STAGE(PG8_SA(0, 0), a2, voffA);
            PG8_BAR; PG8_WAIT_L(0); PG8_MMA(1, 0, At, B0); PG8_BAR; PG8_SCHED;
            PG8_STAGE(PG8_SB(0, 1), b2 + hstep, voffB);
            PG8_WAIT_V(6); PG8_BAR; PG8_MMA(1, 1, At, B1); PG8_BAR;
            PG8_LDB(B0, 1, 0); PG8_SCHED; PG8_LDA(At, 1, 0); PG8_STAGE(PG8_SA(0, 1), a2 + hstep, voffA);
            PG8_WAIT_L(8); PG8_BAR; PG8_WAIT_L(0); PG8_MMA(0, 0, At, B0); PG8_BAR; PG8_SCHED;
            PG8_LDB(B1, 1, 1); PG8_STAGE(PG8_SB(1, 0), b3, voffB);
            PG8_BAR; PG8_WAIT_L(0); PG8_MMA(0, 1, At, B1); PG8_BAR;
            PG8_LDA(At, 1, 1); PG8_STAGE(PG8_SA(1, 0), a3, voffA);
            PG8_BAR; PG8_WAIT_L(0); PG8_MMA(1, 0, At, B0); PG8_BAR; PG8_SCHED;
            PG8_STAGE(PG8_SB(1, 1), b3 + hstep, voffB);
            PG8_WAIT_V(6); PG8_BAR; PG8_MMA(1, 1, At, B1); PG8_BAR;
            }
        }
        if constexpr (ALIGN_EPI) { if (wr == 0) PG8_BAR; }
        if constexpr (!Epi::AFTER_DRAIN) { E(acc, cur, wr, wc, fr, fq); S.done(cur); }
        if (!has_next) break;
#pragma unroll
        for (int a = 0; a < 2; ++a)
#pragma unroll
            for (int b = 0; b < 2; ++b)
#pragma unroll
                for (int m = 0; m < 4; ++m)
#pragma unroll
                    for (int n = 0; n < 2; ++n) acc[a][b][m][n] = (f32x4){0.f, 0.f, 0.f, 0.f};
        cur = nxt; cA = nA; cB = nB; ++ui;
        if constexpr (ALIGN_EPI) { if (wr == 1) PG8_BAR; }
    }
    PG8_WAIT_V(0);
    if constexpr (!ALIGN_EPI) { if (wr == 0) PG8_BAR; }
    PG8_BAR;
    if constexpr (Epi::AFTER_DRAIN) { E.fused(acc, cur, wr, wc, fr, fq, lds, wid, lane); S.done(cur); }
#undef PG8_SA
#undef PG8_SB
#undef PG8_STAGE
#undef PG8_LDA
#undef PG8_LDB
#undef PG8_MMA
#undef PG8_WAIT_V
#undef PG8_WAIT_L
#undef PG8_BAR
#undef PG8_SCHED
}
}

#ifndef PG8_SP2
#define PG8_SP2 true
#endif
#ifndef PG8_ALIGN
#define PG8_ALIGN true
#endif
#ifndef MK_ONE_LAUNCH
#define MK_ONE_LAUNCH 1
#endif

constexpr int NWAVES = 8, NTHR = NWAVES * 64;
constexpr int D = 1024, DEPTH = 4, SEQ = 4096, NB_P = 4, NB_S = 128, T_S = 4;
constexpr int MP = NB_P * SEQ, MS = NB_S * T_S, M = MP + MS;
constexpr int NPROJ = 3072, NPROJ_REAL = 2824, FF = 4096, NMOD = 6 * D, CONVCH = 1536;
constexpr int PC_QA = 0, PC_KA = 512, PC_VA = 1024, PC_Z = 1536, PC_QB = 2048, PC_KB = 2560, PC_VB = 2688, PC_BLG = 2816, PC_ALG = 2820;
constexpr float EPS = 1e-6f;
constexpr size_t OY_P = 0, OY_S = OY_P + (size_t)MP * D, OCONV_P = OY_S + (size_t)MS * D, OSSM_P = OCONV_P + (size_t)DEPTH * NB_P * 3 * CONVCH,
    OK_P = OSSM_P + (size_t)DEPTH * NB_P * 4 * 128 * 128, OV_P = OK_P + (size_t)DEPTH * NB_P * 128 * 128, OCONV_S = OV_P + (size_t)DEPTH * NB_P * 128 * 128,
    OSSM_S = OCONV_S + (size_t)DEPTH * NB_S * 3 * CONVCH, OK_S = OSSM_S + (size_t)DEPTH * NB_S * 4 * 128 * 128, OV_S = OK_S + (size_t)DEPTH * NB_S * 128 * 128,
    OUT_TOTAL = OV_S + (size_t)DEPTH * NB_S * 128 * 128;
static_assert(OUT_TOTAL == 71639040, "output size");

constexpr size_t MiB = 1u << 20;
constexpr size_t WS_CTL = 0, CTL_ZERO_BYTES = 1 * MiB;
constexpr size_t WS_WIN = 1 * MiB, WS_WO = 25 * MiB, WS_WUP = 33 * MiB, WS_WDN = 65 * MiB;
constexpr size_t WS_SC = 97 * MiB;
constexpr size_t WS_MOD = 98 * MiB;
constexpr size_t WS_X = 122 * MiB;
constexpr size_t WS_XN = 188 * MiB;
constexpr size_t WS_PROJ = 221 * MiB;
constexpr size_t WS_O = 320 * MiB;
constexpr size_t WS_H = 221 * MiB;
constexpr size_t WS_MIX = 353 * MiB;
constexpr size_t WS_WADA = 419 * MiB;
constexpr size_t WS_END = 467 * MiB;
static_assert(WS_PROJ + (size_t)M * NPROJ * 2 <= WS_O && WS_O + (size_t)M * D * 2 <= WS_MIX && WS_H + (size_t)M * FF * 2 <= WS_MIX && WS_MIX + (size_t)M * D * 4 <= WS_WADA, "ws map");
static_assert(WS_X + (size_t)M * D * 4 <= WS_XN && WS_XN + (size_t)M * D * 2 <= WS_PROJ && WS_MOD + (size_t)256 * 24576 * 4 <= WS_X, "ws map 2");
constexpr int CW_BAR = 4096;

constexpr int RING_OFF = 0, RING_BYTES = 131072;
constexpr int LDSCTL_OFF = RING_BYTES, MISC_OFF = LDSCTL_OFF + 320;
constexpr int LDS_BYTES = 147456;

#define GAS __attribute__((address_space(1)))
#define LAS __attribute__((address_space(3)))
typedef unsigned short bf16;
typedef unsigned v4u __attribute__((ext_vector_type(4)));
typedef float f32x4 __attribute__((ext_vector_type(4)));
typedef GAS unsigned gu32;
#define LDS_WAIT() asm volatile("s_waitcnt lgkmcnt(0)" ::: "memory")
#define VM_WAIT() asm volatile("s_waitcnt vmcnt(0)" ::: "memory")
__device__ __forceinline__ unsigned f2bf(float f) { unsigned u = __builtin_bit_cast(unsigned, f); return (u + 0x7fffu + ((u >> 16) & 1u)) >> 16; }
__device__ __forceinline__ unsigned pk2(float lo, float hi) { return f2bf(lo) | (f2bf(hi) << 16); }
__device__ __forceinline__ float bf2f(bf16 h) { return __builtin_bit_cast(float, (unsigned)h << 16); }
__device__ __forceinline__ float bflo(unsigned w) { return __builtin_bit_cast(float, w << 16); }
__device__ __forceinline__ float bfhi(unsigned w) { return __builtin_bit_cast(float, w & 0xffff0000u); }
__device__ __forceinline__ float wave_sum(float v) {
#pragma unroll
    for (int o = 1; o < 64; o <<= 1) v += __shfl_xor(v, o);
    return v;
}
__device__ __forceinline__ float wave_max(float v) {
#pragma unroll
    for (int o = 1; o < 64; o <<= 1) v = fmaxf(v, __shfl_xor(v, o));
    return v;
}
__device__ __forceinline__ float siluf(float x) { return x / (1.f + __expf(-x)); }
__device__ __forceinline__ float sigmf(float x) { return 1.f / (1.f + __expf(-x)); }
__device__ __forceinline__ float softplusf(float x) { return x > 20.f ? x : log1pf(__expf(x)); }

struct Frame {
    LAS unsigned char* lds;
    int tid, lane, wave, G, bid;
    float* out; unsigned char* ws;
};
__device__ __forceinline__ unsigned char* wsp(const Frame& F) { unsigned char* p = F.ws; asm volatile("" : "+s"(p)); return p; }
constexpr int TAB_OFF = LDSCTL_OFF + 1024;
__device__ __forceinline__ const float* inp(const Frame& F, int i) {
    const unsigned long long v = ((const LAS unsigned long long*)(F.lds + TAB_OFF))[i];
    const unsigned lo = __builtin_amdgcn_readfirstlane((unsigned)v), hi = __builtin_amdgcn_readfirstlane((unsigned)(v >> 32));
    return (const float*)(((unsigned long long)hi << 32) | lo);
}
#define IN_XP 0
#define IN_XS 1
#define IN_SCONV 2
#define IN_SSSM 3
#define IN_CK 4
#define IN_CV 5
#define IN_CP 6
#define IN_CS 7
#define IN_GPREM 8
#define IN_GPOSTM 9
#define IN_GPREF 10
#define IN_GPOSTF 11
#define IN_WADA 12
#define IN_BADA 13
#define IN_WIN 14
#define IN_CONVW 15
#define IN_ALOG 16
#define IN_DTB 17
#define IN_GDNW 18
#define IN_SINKS 19
#define IN_WO 20
#define IN_WUP 21
#define IN_WDN 22

template <int MAPKIND  >
__device__ __forceinline__ void p0_transpose_item(const float* W, int K, int N, int Ndst, bf16* WT, LAS float* scr, int item, int lane) {
    const int nblk = Ndst / 32, kb = item / nblk, nb = item % nblk, k0 = 64 * kb, n0 = 32 * nb;
    const int nd = n0 + (lane & 31);
    int ns = nd;
    if (MAPKIND == 1) { ns = nd < 2048 ? nd : (nd < 2816 ? nd + 8 : (nd < 2824 ? nd - 768 : -1)); }
#pragma unroll 8
    for (int i = 0; i < 32; ++i) { const int kk = 2 * i + (lane >> 5); scr[kk * 33 + (lane & 31)] = (ns >= 0) ? W[(size_t)(k0 + kk) * N + ns] : 0.f; }
    LDS_WAIT(); asm volatile("" ::: "memory");
    const int c = lane & 7;
#pragma unroll
    for (int j = 0; j < 4; ++j) { const int n = (lane >> 3) + 8 * j; const LAS float* s = scr + (8 * c) * 33 + n;
        v4u o; o.x = pk2(s[0 * 33], s[1 * 33]); o.y = pk2(s[2 * 33], s[3 * 33]); o.z = pk2(s[4 * 33], s[5 * 33]); o.w = pk2(s[6 * 33], s[7 * 33]);
        *(GAS v4u*)(WT + (size_t)(n0 + n) * K + k0 + 8 * c) = o; }
    LDS_WAIT(); asm volatile("" ::: "memory");
}

__device__ __forceinline__ void p0_prologue(Frame& F) {
    LAS float* scr = (LAS float*)(F.lds + RING_OFF + F.wave * 16384);
    const int gw = F.bid * NWAVES + F.wave, NGW = F.G * NWAVES;
    constexpr int I_IN = (D / 64) * (NPROJ / 32), I_O = (D / 64) * (D / 32), I_UP = (D / 64) * (FF / 32), I_DN = (FF / 64) * (D / 32), I_ADA = (D / 64) * (NMOD / 32);
    constexpr int PER_L = I_IN + I_O + I_UP + I_DN + I_ADA;
    for (int it = gw; it < DEPTH * PER_L; it += NGW) {
        const int l = it / PER_L; int r = it % PER_L;
        if (r < I_IN) { p0_transpose_item<1>(inp(F, IN_WIN) + (size_t)l * D * NPROJ_REAL, D, NPROJ_REAL, NPROJ, (bf16*)(wsp(F) + WS_WIN) + (size_t)l * NPROJ * D, scr, r, F.lane); continue; } r -= I_IN;
        if (r < I_O) { p0_transpose_item<0>(inp(F, IN_WO) + (size_t)l * D * D, D, D, D, (bf16*)(wsp(F) + WS_WO) + (size_t)l * D * D, scr, r, F.lane); continue; } r -= I_O;
        if (r < I_UP) { p0_transpose_item<0>(inp(F, IN_WUP) + (size_t)l * D * FF, D, FF, FF, (bf16*)(wsp(F) + WS_WUP) + (size_t)l * FF * D, scr, r, F.lane); continue; } r -= I_UP;
        if (r < I_DN) { p0_transpose_item<0>(inp(F, IN_WDN) + (size_t)l * FF * D, FF, D, D, (bf16*)(wsp(F) + WS_WDN) + (size_t)l * D * FF, scr, r, F.lane); continue; } r -= I_DN;
        p0_transpose_item<0>(inp(F, IN_WADA) + (size_t)l * D * NMOD, D, NMOD, NMOD, (bf16*)(wsp(F) + WS_WADA) + (size_t)l * NMOD * D, scr, r, F.lane);
    }
    bf16* SC = (bf16*)(wsp(F) + WS_SC);
    for (int i = F.bid * NTHR + F.tid; i < 256 * D; i += F.G * NTHR) {
        const int r = i >> 10, c = i & 1023; float v = 0.f;
        if (r < NB_P) v = siluf(inp(F, IN_CP)[r * D + c]); else if (r < NB_P + NB_S) v = siluf(inp(F, IN_CS)[(r - NB_P) * D + c]);
        SC[i] = (bf16)f2bf(v);
    }
}

__device__ __forceinline__ const float* modp(Frame& F, int row, int l, int j) {
    const int mrow = row < MP ? (row >> 12) : NB_P + ((row - MP) >> 2);
    return (const float*)(wsp(F) + WS_MOD) + (size_t)mrow * (DEPTH * NMOD) + l * NMOD + j * D;
}
__device__ __forceinline__ void modnorm_store(Frame& F, const f32x4 (&v)[4], const float* g, const float* scale, const float* shift, bf16* orow) {
    float s = 0.f;
#pragma unroll
    for (int j = 0; j < 4; ++j) s += (v[j].x * v[j].x + v[j].y * v[j].y) + (v[j].z * v[j].z + v[j].w * v[j].w);
    const float rs = 1.0f / sqrtf(wave_sum(s) * (1.f / D) + EPS);
    GAS unsigned long long* o8 = (GAS unsigned long long*)orow + F.lane;
#pragma unroll
    for (int j = 0; j < 4; ++j) {
        const f32x4 gg = ((const f32x4*)g)[F.lane + 64 * j], sc = ((const f32x4*)scale)[F.lane + 64 * j], sh = ((const f32x4*)shift)[F.lane + 64 * j];
        const f32x4 h = (v[j] * rs) * gg * (sc + 1.0f) + sh;
        o8[64 * j] = (unsigned long long)pk2(h.x, h.y) | ((unsigned long long)pk2(h.z, h.w) << 32);
    }
}
__device__ __forceinline__ const float* xin_row(Frame& F, int row) { return row < MP ? inp(F, IN_XP) + (size_t)row * D : inp(F, IN_XS) + (size_t)(row - MP) * D; }
__device__ __forceinline__ void rowpass0(Frame& F) {
    const int gw = F.bid * NWAVES + F.wave, NGW = F.G * NWAVES;
    for (int row = gw; row < M; row += NGW) {
        const f32x4* xr = (const f32x4*)xin_row(F, row) + F.lane; f32x4 v[4];
#pragma unroll
        for (int j = 0; j < 4; ++j) v[j] = xr[64 * j];
        modnorm_store(F, v, inp(F, IN_GPREM), modp(F, row, 0, 1), modp(F, row, 0, 0), (bf16*)(wsp(F) + WS_XN) + (size_t)row * D);
    }
}
__device__ __forceinline__ void rowpass12(Frame& F, int l, int kind) {
    const int gw = F.bid * NWAVES + F.wave, NGW = F.G * NWAVES;
    float* X = (float*)(wsp(F) + WS_X); const float* MIX = (const float*)(wsp(F) + WS_MIX);
    for (int row = gw; row < M; row += NGW) {
        const float* xsrc = (l == 0 && kind == 1) ? xin_row(F, row) : X + (size_t)row * D;
        const f32x4* xr = (const f32x4*)xsrc + F.lane; const f32x4* mr = (const f32x4*)(MIX + (size_t)row * D) + F.lane;
        f32x4 x[4], m[4]; float s = 0.f;
#pragma unroll
        for (int j = 0; j < 4; ++j) { x[j] = xr[64 * j]; m[j] = mr[64 * j]; s += (m[j].x * m[j].x + m[j].y * m[j].y) + (m[j].z * m[j].z + m[j].w * m[j].w); }
        const float rs = 1.0f / sqrtf(wave_sum(s) * (1.f / D) + EPS);
        const float* gpost = inp(F, kind == 1 ? IN_GPOSTM : IN_GPOSTF) + l * D; const float* gate = modp(F, row, l, kind == 1 ? 2 : 5);
#pragma unroll
        for (int j = 0; j < 4; ++j) { const f32x4 gp = ((const f32x4*)gpost)[F.lane + 64 * j], gt = ((const f32x4*)gate)[F.lane + 64 * j]; x[j] = x[j] + gt * ((m[j] * rs) * gp); }
        const bool fin = (kind == 2 && l == DEPTH - 1);
        float* xdst = fin ? (row < MP ? F.out + OY_P + (size_t)row * D : F.out + OY_S + (size_t)(row - MP) * D) : X + (size_t)row * D;
#pragma unroll
        for (int j = 0; j < 4; ++j) ((f32x4*)xdst)[F.lane + 64 * j] = x[j];
        if (!fin) {
            if (kind == 1) modnorm_store(F, x, inp(F, IN_GPREF) + l * D, modp(F, row, l, 4), modp(F, row, l, 3), (bf16*)(wsp(F) + WS_XN) + (size_t)row * D);
            else modnorm_store(F, x, inp(F, IN_GPREM) + (l + 1) * D, modp(F, row, l + 1, 1), modp(F, row, l + 1, 0), (bf16*)(wsp(F) + WS_XN) + (size_t)row * D);
        }
    }
}

__device__ __forceinline__ void gdn_naive_item(Frame& F, int l, int row0, int T, int h, const float* S0, const float* cbuf, float* Sout, float* convout) {
    LAS float* sm = (LAS float*)(F.lds + RING_OFF);
    LAS float* red = sm + 384; LAS float* red2 = sm + 896; LAS float* part = sm + 1408; LAS float* part2 = sm + 1416; LAS float* scal = sm + 1424;
    const int tid = F.tid, v = tid & 127, kq = tid >> 7;
    const bf16* PROJ = (const bf16*)(wsp(F) + WS_PROJ); bf16* O = (bf16*)(wsp(F) + WS_O);
    float S[32];
#pragma unroll
    for (int i = 0; i < 32; ++i) S[i] = S0 ? S0[(kq * 32 + i) * 128 + v] : 0.f;
    float x1 = 0.f, x2 = 0.f, x3 = 0.f, cw0 = 0.f, cw1 = 0.f, cw2 = 0.f, cw3 = 0.f; int ch = 0;
    if (tid < 384) {
        ch = (tid >> 7) * 512 + h * 128 + (tid & 127);
        const float* cw = inp(F, IN_CONVW) + (size_t)l * 4 * CONVCH;
        cw0 = cw[ch]; cw1 = cw[CONVCH + ch]; cw2 = cw[2 * CONVCH + ch]; cw3 = cw[3 * CONVCH + ch];
        if (cbuf) { x1 = cbuf[ch]; x2 = cbuf[CONVCH + ch]; x3 = cbuf[2 * CONVCH + ch]; }
    }
    const float Aexp = __expf(inp(F, IN_ALOG)[l * 4 + h]), dtb = inp(F, IN_DTB)[l * 4 + h];
    const float gw = inp(F, IN_GDNW)[l * 128 + v];
    __syncthreads();
    for (int t = 0; t < T; ++t) {
        const size_t row = (size_t)(row0 + t); const bf16* prow = PROJ + row * NPROJ;
        if (tid < 384) {
            const float x = bf2f(prow[ch]);
            const float a = cw0 * x1 + cw1 * x2 + cw2 * x3 + cw3 * x; x1 = x2; x2 = x3; x3 = x;
            const float xc = siluf(a); sm[tid] = xc;
            const float ss = wave_sum(xc * xc); if (F.lane == 0) part[F.wave] = ss;
        }
        if (tid == 384) {
            const float bl = bf2f(prow[PC_BLG + h]), al = bf2f(prow[PC_ALG + h]);
            scal[0] = sigmf(bl); scal[1] = __expf(-Aexp * softplusf(al + dtb));
        }
        __syncthreads();
        const float rq = (1.0f / sqrtf(part[0] + part[1] + EPS)) * 0.08838834764831845f, rk = 1.0f / sqrtf(part[2] + part[3] + EPS);
        const float beta = scal[0], a = scal[1];
        float p = 0.f;
#pragma unroll
        for (int i = 0; i < 32; ++i) { S[i] *= a; p += S[i] * (sm[128 + kq * 32 + i] * rk); }
        red[kq * 128 + v] = p;
        __syncthreads();
        const float tot = (red[v] + red[128 + v]) + (red[256 + v] + red[384 + v]);
        const float coef = beta * (sm[256 + v] - tot);
        float op = 0.f;
#pragma unroll
        for (int i = 0; i < 32; ++i) { S[i] += (sm[128 + kq * 32 + i] * rk) * coef; op += S[i] * (sm[kq * 32 + i] * rq); }
        red2[kq * 128 + v] = op;
        __syncthreads();
        float o = 0.f;
        if (tid < 128) { o = (red2[v] + red2[128 + v]) + (red2[256 + v] + red2[384 + v]); const float ss = wave_sum(o * o); if (F.lane == 0) part2[F.wave] = ss; }
        __syncthreads();
        if (tid < 128) {
            const float rn = 1.0f / sqrtf((part2[0] + part2[1]) * (1.f / 128.f) + EPS);
            const float z = bf2f(prow[PC_Z + h * 128 + v]);
            O[row * D + h * 128 + v] = (bf16)f2bf(o * rn * gw * siluf(z));
        }
    }
#pragma unroll
    for (int i = 0; i < 32; ++i) Sout[(kq * 32 + i) * 128 + v] = S[i];
    if (tid < 384) { convout[ch] = x1; convout[CONVCH + ch] = x2; convout[2 * CONVCH + ch] = x3; }
    __syncthreads();
}

__device__ __forceinline__ void swa_naive_item(Frame& F, int l, int row, int kvh) {
    LAS float* scw = (LAS float*)(F.lds + RING_OFF + 8192 + F.wave * 2048);
    const bf16* PROJ = (const bf16*)(wsp(F) + WS_PROJ); bf16* O = (bf16*)(wsp(F) + WS_O);
    const int lane = F.lane;
    const bool samp = row >= MP;
    const int b = samp ? (row - MP) >> 2 : row >> 12, t = samp ? (row - MP) & 3 : row & 4095;
    const int seq0 = samp ? MP + b * 4 : b * SEQ;
    const bf16* prow = PROJ + (size_t)row * NPROJ;
    float qv[4];
#pragma unroll
    for (int g = 0; g < 4; ++g) qv[g] = bf2f(prow[PC_QB + (kvh * 4 + g) * 64 + lane]);
    const float* ck = inp(F, IN_CK) + ((size_t)(l * NB_S + b) * 128) * 128 + kvh * 64;
    const float* cv = inp(F, IN_CV) + ((size_t)(l * NB_S + b) * 128) * 128 + kvh * 64;
#pragma unroll 2
    for (int ci = 0; ci < 128; ++ci) {
        float kv; bool valid = true;
        if (!samp) { int s = t - 127 + ci; valid = s >= 0; s = valid ? s : 0; kv = bf2f(PROJ[(size_t)(seq0 + s) * NPROJ + PC_KB + kvh * 64 + lane]); }
        else { const int cidx = t + 1 + ci; kv = cidx < 128 ? ck[(size_t)cidx * 128 + lane] : bf2f(PROJ[(size_t)(seq0 + cidx - 128) * NPROJ + PC_KB + kvh * 64 + lane]); }
#pragma unroll
        for (int g = 0; g < 4; ++g) { const float s = wave_sum(qv[g] * kv); if (lane == 0) scw[g * 128 + ci] = valid ? s * 0.125f : -INFINITY; }
    }
    LDS_WAIT(); asm volatile("" ::: "memory");
#pragma unroll
    for (int g = 0; g < 4; ++g) {
        const float sk = inp(F, IN_SINKS)[l * 8 + kvh * 4 + g];
        const float s0 = scw[g * 128 + lane], s1 = scw[g * 128 + 64 + lane];
        const float mx = fmaxf(wave_max(fmaxf(s0, s1)), sk);
        const float p0 = __expf(s0 - mx), p1 = __expf(s1 - mx);
        const float den = wave_sum(p0 + p1) + __expf(sk - mx);
        scw[g * 128 + lane] = p0 / den; scw[g * 128 + 64 + lane] = p1 / den;
    }
    LDS_WAIT(); asm volatile("" ::: "memory");
    float o[4] = {0.f, 0.f, 0.f, 0.f};
#pragma unroll 2
    for (int ci = 0; ci < 128; ++ci) {
        float vv;
        if (!samp) { int s = t - 127 + ci; s = s < 0 ? 0 : s; vv = bf2f(PROJ[(size_t)(seq0 + s) * NPROJ + PC_VB + kvh * 64 + lane]); }
        else { const int cidx = t + 1 + ci; vv = cidx < 128 ? cv[(size_t)cidx * 128 + lane] : bf2f(PROJ[(size_t)(seq0 + cidx - 128) * NPROJ + PC_VB + kvh * 64 + lane]); }
#pragma unroll
        for (int g = 0; g < 4; ++g) o[g] += scw[g * 128 + ci] * vv;
    }
#pragma unroll
    for (int g = 0; g < 4; ++g) O[(size_t)row * D + 512 + (kvh * 4 + g) * 64 + lane] = (bf16)f2bf(o[g]);
    LDS_WAIT(); asm volatile("" ::: "memory");
}

__device__ __forceinline__ void mixers_naive(Frame& F, int l) {
    const bf16* PROJ = (const bf16*)(wsp(F) + WS_PROJ);
    if (F.bid < 16) {
        const int b = F.bid >> 2, h = F.bid & 3;
        gdn_naive_item(F, l, b * SEQ, SEQ, h, nullptr, nullptr, F.out + OSSM_P + ((size_t)(l * NB_P + b) * 4 + h) * 16384, F.out + OCONV_P + (size_t)(l * NB_P + b) * 3 * CONVCH);
        return;
    }
    const int wg = F.bid - 16, nwg = F.G - 16;
    for (int it = wg; it < NB_S * 4; it += nwg) {
        const int b = it >> 2, h = it & 3;
        gdn_naive_item(F, l, MP + b * T_S, T_S, h, inp(F, IN_SSSM) + ((size_t)(l * NB_S + b) * 4 + h) * 16384, inp(F, IN_SCONV) + (size_t)(l * NB_S + b) * 3 * CONVCH,
                       F.out + OSSM_S + ((size_t)(l * NB_S + b) * 4 + h) * 16384, F.out + OCONV_S + (size_t)(l * NB_S + b) * 3 * CONVCH);
    }
    for (int it = wg * NWAVES + F.wave; it < M * 2; it += nwg * NWAVES) swa_naive_item(F, l, it >> 1, it & 1);
    const int gt = wg * NTHR + F.tid, ngt = nwg * NTHR;
    for (int i = gt; i < NB_P * 128 * 128; i += ngt) {
        const int b = i >> 14, j = (i >> 7) & 127, c = i & 127; const bf16* prow = PROJ + (size_t)(b * SEQ + SEQ - 128 + j) * NPROJ;
        F.out[OK_P + (size_t)l * NB_P * 16384 + i] = bf2f(prow[PC_KB + c]); F.out[OV_P + (size_t)l * NB_P * 16384 + i] = bf2f(prow[PC_VB + c]);
    }
    for (int i = gt; i < NB_S * 128 * 128; i += ngt) {
        const int b = i >> 14, j = (i >> 7) & 127, c = i & 127; float kk, vv;
        if (j < 124) { const size_t src = ((size_t)(l * NB_S + b) * 128 + j + 4) * 128 + c; kk = inp(F, IN_CK)[src]; vv = inp(F, IN_CV)[src]; }
        else { const bf16* prow = PROJ + (size_t)(MP + b * T_S + (j - 124)) * NPROJ; kk = bf2f(prow[PC_KB + c]); vv = bf2f(prow[PC_VB + c]); }
        F.out[OK_S + (size_t)l * NB_S * 16384 + i] = kk; F.out[OV_S + (size_t)l * NB_S * 16384 + i] = vv;
    }
}

struct Args { const float* in[23]; float* out; unsigned char* ws; int ph_lo, ph_hi; };
constexpr int NPH = 3 + 7 * DEPTH;

__global__ void __launch_bounds__(NTHR, 2) mega_fwd(Args args) {
    extern __shared__ __attribute__((aligned(16))) unsigned char lds[];
    Frame F;
    F.lds = (LAS unsigned char*)lds;
    F.tid = threadIdx.x; F.lane = F.tid & 63; F.wave = __builtin_amdgcn_readfirstlane(F.tid >> 6);
    F.G = gridDim.x; F.bid = blockIdx.x;
    if (F.tid < 23) ((LAS unsigned long long*)(F.lds + TAB_OFF))[F.tid] = (unsigned long long)args.in[F.tid];
    F.out = args.out; F.ws = args.ws;
    __syncthreads();
#if MK_ONE_LAUNCH
    cooperative_groups::grid_group grid = cooperative_groups::this_grid();
#endif
    for (int ph = args.ph_lo; ph < args.ph_hi; ++ph) {
        { int t_ = threadIdx.x; asm volatile("" : "+v"(t_)); F.tid = t_; F.lane = t_ & 63; F.wave = __builtin_amdgcn_readfirstlane(t_ >> 6); }
        int kind, l = 0;
        if (ph < 3) kind = ph; else { l = (ph - 3) / 7; kind = 3 + (ph - 3) % 7; }
        if (kind == 0) p0_prologue(F);
        else if (kind == 2) rowpass0(F);
        else if (kind == 4) mixers_naive(F, l);
        else if (kind == 6) rowpass12(F, l, 1);
        else if (kind == 9) rowpass12(F, l, 2);
        else if (kind == 3) {
            pg8::Gemm g{(const bf16*)(wsp(F) + WS_XN), (const bf16*)(wsp(F) + WS_WIN) + (size_t)l * NPROJ * D, M, NPROJ, D};
            pg8::StaticOrder S; S.init(M, NPROJ, F.G, F.bid);
            pg8::EpiBf16<0> E{(bf16*)(wsp(F) + WS_PROJ), NPROJ};
            pg8::gemm_phase<pg8::EpiBf16<0>, pg8::StaticOrder, PG8_ALIGN, PG8_SP2>(F.lds + RING_OFF, g, S, E, F.tid);
        } else if (kind == 7) {
            pg8::Gemm g{(const bf16*)(wsp(F) + WS_XN), (const bf16*)(wsp(F) + WS_WUP) + (size_t)l * FF * D, M, FF, D};
            pg8::StaticOrder S; S.init(M, FF, F.G, F.bid);
            pg8::EpiBf16<2> E{(bf16*)(wsp(F) + WS_H), FF};
            pg8::gemm_phase<pg8::EpiBf16<2>, pg8::StaticOrder, PG8_ALIGN, PG8_SP2>(F.lds + RING_OFF, g, S, E, F.tid);
        } else {
            pg8::Gemm g; pg8::EpiF32 E;
            if (kind == 1) { g = pg8::Gemm{(const bf16*)(wsp(F) + WS_SC), (const bf16*)(wsp(F) + WS_WADA), 256, DEPTH * NMOD, D}; E = pg8::EpiF32{(float*)(wsp(F) + WS_MOD), DEPTH * NMOD, inp(F, IN_BADA)}; }
            else if (kind == 5) { g = pg8::Gemm{(const bf16*)(wsp(F) + WS_O), (const bf16*)(wsp(F) + WS_WO) + (size_t)l * D * D, M, D, D}; E = pg8::EpiF32{(float*)(wsp(F) + WS_MIX), D, nullptr}; }
            else { g = pg8::Gemm{(const bf16*)(wsp(F) + WS_H), (const bf16*)(wsp(F) + WS_WDN) + (size_t)l * D * FF, M, D, FF}; E = pg8::EpiF32{(float*)(wsp(F) + WS_MIX), D, nullptr}; }
            pg8::StaticOrder S; S.init(g.M, g.N, F.G, F.bid);
            pg8::gemm_phase<pg8::EpiF32, pg8::StaticOrder, PG8_ALIGN, PG8_SP2>(F.lds + RING_OFF, g, S, E, F.tid);
        }
#if MK_ONE_LAUNCH
        if (ph + 1 < args.ph_hi) grid.sync();
#endif
    }
}

extern "C" void kernel_launch(void* const* d_in, const int* in_sizes, int n_in, void* d_out, int out_size, void* d_ws, size_t ws_size, hipStream_t stream) {
    static int grid = 0;
    if (grid == 0) {
        if (n_in != 23 || (size_t)out_size != OUT_TOTAL || ws_size < WS_END) { fprintf(stderr, "kernel_launch: unexpected shapes n_in %d out %d ws %zu\n", n_in, out_size, ws_size); grid = -1; return; }
        int dev = 0, cus = 0, per_cu = 0;
        if (hipGetDevice(&dev) != hipSuccess || hipDeviceGetAttribute(&cus, hipDeviceAttributeMultiprocessorCount, dev) != hipSuccess) { grid = -1; return; }
        if (hipFuncSetAttribute((const void*)mega_fwd, hipFuncAttributeMaxDynamicSharedMemorySize, LDS_BYTES) != hipSuccess) { fprintf(stderr, "kernel_launch: hipFuncSetAttribute failed\n"); grid = -1; return; }
        if (hipOccupancyMaxActiveBlocksPerMultiprocessor(&per_cu, (const void*)mega_fwd, NTHR, LDS_BYTES) != hipSuccess || per_cu < 1) { fprintf(stderr, "kernel_launch: occupancy query says %d\n", per_cu); per_cu = 1; }
        (void)hipGetLastError();
        grid = cus;
    }
    if (grid < 0) return;
    Args a{};
    for (int i = 0; i < 23; ++i) a.in[i] = (const float*)d_in[i];
    a.out = (float*)d_out; a.ws = (unsigned char*)d_ws;
#if MK_ONE_LAUNCH
    a.ph_lo = 0; a.ph_hi = NPH;
    void* kargs[] = {&a};
    hipError_t e = hipLaunchCooperativeKernel((const void*)mega_fwd, dim3(grid), dim3(NTHR), kargs, LDS_BYTES, stream);
    if (e != hipSuccess) fprintf(stderr, "cooperative launch failed: %s (grid %d)\n", hipGetErrorString(e), grid);
#else
    for (int ph = 0; ph < NPH; ++ph) {
        a.ph_lo = ph; a.ph_hi = ph + 1;
        hipLaunchKernelGGL(mega_fwd, dim3(grid), dim3(NTHR), LDS_BYTES, stream, a);
    }
#endif
}
```

```cpp
#include <hip/hip_runtime.h>
#include <hip/hip_cooperative_groups.h>
#include <cstdio>
#include <cstdint>
#include <cmath>
namespace pg8 {
#define PG8_LAS __attribute__((address_space(3)))
typedef unsigned short bf16_t;
typedef short bf16x8 __attribute__((ext_vector_type(8)));
typedef float f32x4 __attribute__((ext_vector_type(4)));
typedef unsigned u32x4 __attribute__((ext_vector_type(4)));
constexpr int BM = 256, BK = 64, HALF = 128, HTB = HALF * BK * 2  , STAGE_BYTES = 8 * HTB, NXCD = 8, WGM = 8;

__host__ __device__ __forceinline__ int lds_byte(int r, int c) { const int st = (r >> 4) * 2 + (c >> 5), rr = r & 15, cc = c & 31, ob = rr * 64 + cc * 2; return st * 1024 + (ob ^ (((ob >> 9) & 1) << 5)); }
__host__ __device__ __forceinline__ void stage_rc(int b, int& R, int& C) { const int st = b / 1024, sb = b % 1024, swz = sb ^ (((sb >> 9) & 1) << 5); R = (st >> 1) * 16 + swz / 64; C = (st & 1) * 32 + (swz % 64) / 2; }
__host__ __device__ __forceinline__ int perm32(int rho) { const int n = rho >> 4, i = rho & 15; return 8 * (i >> 2) + 4 * n + (i & 3); }

struct Unit { int pm, pn; };
struct Gemm { const bf16_t* A; const bf16_t* Bt; int M, N, K; };

struct StaticOrder {
    int nM, nN, nwg, G, c;
    __host__ __device__ void init(int M, int N, int G_, int c_) { nM = M / BM; nN = N / BM; nwg = nM * nN; G = G_; c = c_; }
    __host__ __device__ bool next(int i, Unit& u) const {
        const long L = (long)i * G + c; if (L >= nwg) return false;
        int wgid = (int)L; { const int q = nwg / NXCD, r = nwg % NXCD, xcd = wgid % NXCD, off = wgid / NXCD; wgid = (xcd < r ? xcd * (q + 1) : r * (q + 1) + (xcd - r) * q) + off; }
        const int nig = WGM * nN, gid = wgid / nig, fm = gid * WGM, gsz = (nM - fm) < WGM ? (nM - fm) : WGM;
        u.pm = fm + ((wgid % nig) % gsz); u.pn = (wgid % nig) / gsz; return true;
    }
    __device__ __forceinline__ void a_ready(const Unit&) const {}
    __device__ __forceinline__ void done(const Unit&) const {}
};


__device__ __forceinline__ unsigned cvt_pk_bf16(float lo, float hi) { unsigned r; asm volatile("v_cvt_pk_bf16_f32 %0, %1, %2" : "=v"(r) : "v"(lo), "v"(hi)); return r; }
struct EpiF32 {
    static constexpr bool PERM = false, AFTER_DRAIN = false;
    float* C; int ldc; const float* bias;
    __device__ __forceinline__ void operator()(const f32x4 (&acc)[2][2][4][2], const Unit& u, int wr, int wc, int fr, int fq) const {
        const int row0 = u.pm * BM + wr * 64 + fr, col0 = u.pn * BM + wc * 32 + 4 * fq;
        f32x4 bv[2][2];
#pragma unroll
        for (int bj = 0; bj < 2; ++bj)
#pragma unroll
            for (int n = 0; n < 2; ++n) bv[bj][n] = bias ? *(const f32x4*)(bias + col0 + bj * HALF + n * 16) : (f32x4){0.f, 0.f, 0.f, 0.f};
#pragma unroll
        for (int ai = 0; ai < 2; ++ai)
#pragma unroll
            for (int m = 0; m < 4; ++m) { float* rowp = C + (size_t)(row0 + ai * HALF + m * 16) * ldc + col0;
#pragma unroll
                for (int bj = 0; bj < 2; ++bj)
#pragma unroll
                    for (int n = 0; n < 2; ++n) *(f32x4*)(rowp + bj * HALF + n * 16) = acc[ai][bj][m][n] + bv[bj][n]; }
    }
};
template <int ACT  > struct EpiBf16 {
    static constexpr bool PERM = true, AFTER_DRAIN = false;
    bf16_t* O; int ldc;
    __device__ __forceinline__ void operator()(const f32x4 (&acc)[2][2][4][2], const Unit& u, int wr, int wc, int fr, int fq) const {
        const int row0 = u.pm * BM + wr * 64 + fr; const int col0 = u.pn * BM + wc * 32 + 8 * fq;
#pragma unroll
        for (int ai = 0; ai < 2; ++ai)
#pragma unroll
            for (int m = 0; m < 4; ++m) { bf16_t* rowp = O + (size_t)(row0 + ai * HALF + m * 16) * ldc + col0;
#pragma unroll
                for (int bj = 0; bj < 2; ++bj) { f32x4 v0 = acc[ai][bj][m][0], v1 = acc[ai][bj][m][1];
                    if (ACT == 2) {
#pragma unroll
                        for (int e = 0; e < 4; ++e) { const float a = fmaxf(v0[e], 0.f), b = fmaxf(v1[e], 0.f); v0[e] = a * a; v1[e] = b * b; } }
                    u32x4 w; w.x = cvt_pk_bf16(v0[0], v0[1]); w.y = cvt_pk_bf16(v0[2], v0[3]); w.z = cvt_pk_bf16(v1[0], v1[1]); w.w = cvt_pk_bf16(v1[2], v1[3]);
                    *(u32x4*)(rowp + bj * HALF) = w; } }
    }
};

template <class Epi, class Sched, bool ALIGN_EPI = false, bool SP2 = false>
__device__ __forceinline__ void gemm_phase(PG8_LAS unsigned char* lds, const Gemm g, const Sched& S, const Epi& E, const int tid) {
    const int wid = __builtin_amdgcn_readfirstlane(tid >> 6), lane = tid & 63, wr = wid >> 2, wc = wid & 3, fr = lane & 15, fq = lane >> 4;
    const int K = g.K, nt = K / BK;
    unsigned voffA[2], voffB[2];
#pragma unroll
    for (int i = 0; i < 2; ++i) { int R, C; stage_rc(tid * 16 + i * 8192, R, C); const int Rb = Epi::PERM ? ((R & ~31) + perm32(R & 31)) : R;
        voffA[i] = (unsigned)(R * K + C) * 2u; voffB[i] = (unsigned)(Rb * K + C) * 2u; }
    const size_t kstep = (size_t)(BK * 2);
    const size_t hstep = (size_t)HALF * K * 2;
    const size_t tstep = 2 * hstep;
    const unsigned ldsw = (unsigned)wid * 1024u;
    const int aoff = lds_byte(wr * 64 + fr, fq * 8), boff = lds_byte(wc * 32 + fr, fq * 8);
#define PG8_SA(b, h) (((b) * 2 + (h)) * HTB)
#define PG8_SB(b, h) ((4 + (b) * 2 + (h)) * HTB)
#define PG8_STAGE(bufoff, gbase, voff) do { _Pragma("unroll") for (int _i = 0; _i < 2; ++_i) \
        __builtin_amdgcn_global_load_lds((const unsigned*)((const char*)(gbase) + (voff)[_i]), (PG8_LAS unsigned*)(lds + (bufoff) + ldsw + _i * 8192), 16, 0, 0); } while (0)
#define PG8_LDA(dst, b, h) do { _Pragma("unroll") for (int m = 0; m < 4; ++m) _Pragma("unroll") for (int k = 0; k < 2; ++k) dst[m][k] = *(const PG8_LAS bf16x8*)(lds + PG8_SA(b, h) + aoff + m * 2048 + k * 1024); } while (0)
#define PG8_LDB(dst, b, h) do { _Pragma("unroll") for (int n = 0; n < 2; ++n) _Pragma("unroll") for (int k = 0; k < 2; ++k) dst[n][k] = *(const PG8_LAS bf16x8*)(lds + PG8_SB(b, h) + boff + n * 2048 + k * 1024); } while (0)
#define PG8_MMA(ai, bj, At, Bt) do { __builtin_amdgcn_s_setprio(1); _Pragma("unroll") for (int m = 0; m < 4; ++m) _Pragma("unroll") for (int n = 0; n < 2; ++n) _Pragma("unroll") for (int k = 0; k < 2; ++k) \
        acc[ai][bj][m][n] = __builtin_amdgcn_mfma_f32_16x16x32_bf16(Bt[n][k], At[m][k], acc[ai][bj][m][n], 0, 0, 0); __builtin_amdgcn_s_setprio(0); } while (0)
#define PG8_WAIT_V(n) asm volatile("s_waitcnt vmcnt(" #n ")" ::: "memory")
#define PG8_WAIT_L(n) asm volatile("s_waitcnt lgkmcnt(" #n ")" ::: "memory")
#define PG8_BAR __builtin_amdgcn_s_barrier()
#define PG8_SCHED __builtin_amdgcn_sched_barrier(0)
    Unit cur, nxt; int ui = 0;
    if (!S.next(0, cur)) return;
    f32x4 acc[2][2][4][2];
#pragma unroll
    for (int a = 0; a < 2; ++a)
#pragma unroll
        for (int b = 0; b < 2; ++b)
#pragma unroll
            for (int m = 0; m < 4; ++m)
#pragma unroll
                for (int n = 0; n < 2; ++n) acc[a][b][m][n] = (f32x4){0.f, 0.f, 0.f, 0.f};
    bf16x8 At[4][2], B0[2][2], B1[2][2];
    const char* cA = (const char*)g.A + (size_t)cur.pm * tstep; const char* cB = (const char*)g.Bt + (size_t)cur.pn * tstep;
    S.a_ready(cur);
    if constexpr (SP2) {
        PG8_STAGE(PG8_SB(0, 0), cB, voffB); PG8_STAGE(PG8_SB(0, 1), cB + hstep, voffB); PG8_STAGE(PG8_SA(0, 0), cA, voffA); PG8_STAGE(PG8_SA(0, 1), cA + hstep, voffA);
        if (wr == 1) PG8_BAR;
        PG8_WAIT_V(2); PG8_BAR;
        PG8_STAGE(PG8_SB(1, 0), cB + kstep, voffB); PG8_STAGE(PG8_SA(1, 0), cA + kstep, voffA); PG8_STAGE(PG8_SB(1, 1), cB + hstep + kstep, voffB);
        PG8_WAIT_V(6); PG8_BAR;
    } else {
        PG8_STAGE(PG8_SB(0, 0), cB, voffB); PG8_STAGE(PG8_SA(0, 0), cA, voffA); PG8_STAGE(PG8_SB(0, 1), cB + hstep, voffB); PG8_STAGE(PG8_SA(0, 1), cA + hstep, voffA);
        if (wr == 1) PG8_BAR;
        PG8_WAIT_V(4); PG8_BAR;
        PG8_STAGE(PG8_SB(1, 0), cB + kstep, voffB); PG8_STAGE(PG8_SA(1, 0), cA + kstep, voffA); PG8_STAGE(PG8_SB(1, 1), cB + hstep + kstep, voffB);
        PG8_WAIT_V(6); PG8_BAR;
    }
    for (;;) {
        const bool has_next = S.next(ui + 1, nxt);
        const char* nA = has_next ? (const char*)g.A + (size_t)nxt.pm * tstep : cA; const char* nB = has_next ? (const char*)g.Bt + (size_t)nxt.pn * tstep : cB;
        for (int t = 0; t < nt; t += 2) {
            const bool last = (t == nt - 2);
            const char* a1 = cA + (size_t)(t + 1) * kstep;
            const char* a2 = last ? nA : cA + (size_t)(t + 2) * kstep; const char* b2 = last ? nB : cB + (size_t)(t + 2) * kstep;
            const char* a3 = a2 + kstep; const char* b3 = b2 + kstep;
            if (last && has_next) S.a_ready(nxt);
            if constexpr (SP2) {
            PG8_LDB(B0, 0, 0); PG8_LDB(B1, 0, 1); PG8_SCHED; PG8_LDA(At, 0, 0); PG8_STAGE(PG8_SA(1, 1), a1 + hstep, voffA);
            PG8_WAIT_V(8); PG8_WAIT_L(0); PG8_BAR; PG8_MMA(0, 0, At, B0); PG8_MMA(0, 1, At, B1); PG8_BAR; PG8_SCHED;
            PG8_LDA(At, 0, 1); PG8_STAGE(PG8_SB(0, 0), b2, voffB); PG8_STAGE(PG8_SB(0, 1), b2 + hstep, voffB); PG8_STAGE(PG8_SA(0, 0), a2, voffA);
            PG8_WAIT_V(8); PG8_WAIT_L(0); PG8_BAR; PG8_MMA(1, 0, At, B0); PG8_MMA(1, 1, At, B1); PG8_BAR; PG8_SCHED;
            PG8_LDB(B0, 1, 0); PG8_LDB(B1, 1, 1); PG8_SCHED; PG8_LDA(At, 1, 0); PG8_STAGE(PG8_SA(0, 1), a2 + hstep, voffA);
            PG8_WAIT_V(8); PG8_WAIT_L(0); PG8_BAR; PG8_MMA(0, 0, At, B0); PG8_MMA(0, 1, At, B1); PG8_BAR; PG8_SCHED;
            PG8_LDA(At, 1, 1); PG8_STAGE(PG8_SB(1, 0), b3, voffB); PG8_STAGE(PG8_SB(1, 1), b3 + hstep, voffB); PG8_STAGE(PG8_SA(1, 0), a3, voffA);
            PG8_WAIT_V(8); PG8_WAIT_L(0); PG8_BAR; PG8_MMA(1, 0, At, B0); PG8_MMA(1, 1, At, B1); PG8_BAR; PG8_SCHED;
            } else {
            PG8_LDB(B0, 0, 0); PG8_SCHED; PG8_LDA(At, 0, 0); PG8_STAGE(PG8_SA(1, 1), a1 + hstep, voffA);
            PG8_WAIT_L(8); PG8_BAR; PG8_WAIT_L(0); PG8_MMA(0, 0, At, B0); PG8_BAR; PG8_SCHED;
            PG8_LDB(B1, 0, 1); PG8_STAGE(PG8_SB(0, 0), b2, voffB);
            PG8_BAR; PG8_WAIT_L(0); PG8_MMA(0, 1, At, B1); PG8_BAR;
            PG8_LDA(At, 0, 1); PG8_STAGE(PG8_SA(0, 0), a2, voffA);
            PG8_BAR; PG8_WAIT_L(0); PG8_MMA(1, 0, At, B0); PG8_BAR; PG8_SCHED;
            PG8_STAGE(PG8_SB(0, 1), b2 + hstep, voffB);
            PG8_WAIT_V(6); PG8_BAR; PG8_MMA(1, 1, At, B1); PG8_BAR;
            PG8_LDB(B0, 1, 0); PG8_SCHED; PG8_LDA(At, 1, 0); PG8_STAGE(PG8_SA(0, 1), a2 + hstep, voffA);
            PG8_WAIT_L(8); PG8_BAR; PG8_WAIT_L(0); PG8_MMA(0, 0, At, B0); PG8_BAR; PG8_SCHED;
            PG8_LDB(B1, 1, 1); PG8_STAGE(PG8_SB(1, 0), b3, voffB);
            PG8_BAR; PG8_WAIT_L(0); PG8_MMA(0, 1, At, B1); PG8_BAR;
            PG8_LDA(At, 1, 1); PG8_STAGE(PG8_SA(1, 0), a3, voffA);
            PG8_BAR; PG8_WAIT_L(0); PG8_MMA(1, 0, At, B0); PG8_BAR; PG8_SCHED;
            PG8_STAGE(PG8_SB(1, 1), b3 + hstep, voffB);
            PG8_WAIT_V(6); PG8_BAR; PG8_MMA(1, 1, At, B1); PG8_BAR;
            }
        }
        if constexpr (ALIGN_EPI) { if (wr == 0) PG8_BAR; }
        if constexpr (!Epi::AFTER_DRAIN) { E(acc, cur, wr, wc, fr, fq); S.done(cur); }
        if (!has_next) break;
#pragma unroll
        for (int a = 0; a < 2; ++a)
#pragma unroll
            for (int b = 0; b < 2; ++b)
#pragma unroll
                for (int m = 0; m < 4; ++m)
#pragma unroll
                    for (int n = 0; n < 2; ++n) acc[a][b][m][n] = (f32x4){0.f, 0.f, 0.f, 0.f};
        cur = nxt; cA = nA; cB = nB; ++ui;
        if constexpr (ALIGN_EPI) { if (wr == 1) PG8_BAR; }
    }
    PG8_WAIT_V(0);
    if constexpr (!ALIGN_EPI) { if (wr == 0) PG8_BAR; }
    PG8_BAR;
    if constexpr (Epi::AFTER_DRAIN) { E.fused(acc, cur, wr, wc, fr, fq, lds, wid, lane); S.done(cur); }
#undef PG8_SA
#undef PG8_SB
#undef PG8_STAGE
#undef PG8_LDA
#undef PG8_LDB
#undef PG8_MMA
#undef PG8_WAIT_V
#undef PG8_WAIT_L
#undef PG8_BAR
#undef PG8_SCHED
}
}

#ifndef PG8_SP2
#define PG8_SP2 true
#endif
#ifndef PG8_ALIGN
#define PG8_ALIGN true
#endif
#ifndef MK_ONE_LAUNCH
#define MK_ONE_LAUNCH 1
#endif

constexpr int NWAVES = 8, NTHR = NWAVES * 64;
constexpr int D = 1024, DEPTH = 4, SEQ = 4096, NB_P = 4, NB_S = 128, T_S = 4;
constexpr int MP = NB_P * SEQ, MS = NB_S * T_S, M = MP + MS;
constexpr int NPROJ = 3072, NPROJ_REAL = 2824, FF = 4096, NMOD = 6 * D, CONVCH = 1536;
constexpr int PC_QA = 0, PC_KA = 512, PC_VA = 1024, PC_Z = 1536, PC_QB = 2048, PC_KB = 2560, PC_VB = 2688, PC_BLG = 2816, PC_ALG = 2820;
constexpr float EPS = 1e-6f;
constexpr size_t OY_P = 0, OY_S = OY_P + (size_t)MP * D, OCONV_P = OY_S + (size_t)MS * D, OSSM_P = OCONV_P + (size_t)DEPTH * NB_P * 3 * CONVCH,
    OK_P = OSSM_P + (size_t)DEPTH * NB_P * 4 * 128 * 128, OV_P = OK_P + (size_t)DEPTH * NB_P * 128 * 128, OCONV_S = OV_P + (size_t)DEPTH * NB_P * 128 * 128,
    OSSM_S = OCONV_S + (size_t)DEPTH * NB_S * 3 * CONVCH, OK_S = OSSM_S + (size_t)DEPTH * NB_S * 4 * 128 * 128, OV_S = OK_S + (size_t)DEPTH * NB_S * 128 * 128,
    OUT_TOTAL = OV_S + (size_t)DEPTH * NB_S * 128 * 128;
static_assert(OUT_TOTAL == 71639040, "output size");

constexpr size_t MiB = 1u << 20;
constexpr size_t WS_CTL = 0, CTL_ZERO_BYTES = 1 * MiB;
constexpr size_t WS_WIN = 1 * MiB, WS_WO = 25 * MiB, WS_WUP = 33 * MiB, WS_WDN = 65 * MiB;
constexpr size_t WS_SC = 97 * MiB;
constexpr size_t WS_MOD = 98 * MiB;
constexpr size_t WS_X = 122 * MiB;
constexpr size_t WS_XN = 188 * MiB;
constexpr size_t WS_PROJ = 221 * MiB;
constexpr size_t WS_O = 320 * MiB;
constexpr size_t WS_H = 221 * MiB;
constexpr size_t WS_MIX = 353 * MiB;
constexpr size_t WS_WADA = 419 * MiB;
constexpr size_t WS_END = 467 * MiB;
static_assert(WS_PROJ + (size_t)M * NPROJ * 2 <= WS_O && WS_O + (size_t)M * D * 2 <= WS_MIX && WS_H + (size_t)M * FF * 2 <= WS_MIX && WS_MIX + (size_t)M * D * 4 <= WS_WADA, "ws map");
static_assert(WS_X + (size_t)M * D * 4 <= WS_XN && WS_XN + (size_t)M * D * 2 <= WS_PROJ && WS_MOD + (size_t)256 * 24576 * 4 <= WS_X, "ws map 2");
constexpr int CW_BAR = 4096;

constexpr int RING_OFF = 0, RING_BYTES = 131072;
constexpr int LDS_BYTES = 155648;
constexpr int SCR_OFF = 148480;
constexpr int CTL_LDS_OFF = 153600, LDSCTL_OFF = CTL_LDS_OFF, MISC_OFF = LDSCTL_OFF + 320;

#define GAS __attribute__((address_space(1)))
#define LAS __attribute__((address_space(3)))
typedef unsigned short bf16;
typedef unsigned v4u __attribute__((ext_vector_type(4)));
typedef float f32x4 __attribute__((ext_vector_type(4)));
typedef GAS unsigned gu32;
#define LDS_WAIT() asm volatile("s_waitcnt lgkmcnt(0)" ::: "memory")
#define VM_WAIT() asm volatile("s_waitcnt vmcnt(0)" ::: "memory")
__device__ __forceinline__ unsigned f2bf(float f) { unsigned u = __builtin_bit_cast(unsigned, f); return (u + 0x7fffu + ((u >> 16) & 1u)) >> 16; }
__device__ __forceinline__ unsigned pk2(float lo, float hi) { return f2bf(lo) | (f2bf(hi) << 16); }
__device__ __forceinline__ float bf2f(bf16 h) { return __builtin_bit_cast(float, (unsigned)h << 16); }
__device__ __forceinline__ float bflo(unsigned w) { return __builtin_bit_cast(float, w << 16); }
__device__ __forceinline__ float bfhi(unsigned w) { return __builtin_bit_cast(float, w & 0xffff0000u); }
__device__ __forceinline__ float wave_sum(float v) {
#pragma unroll
    for (int o = 1; o < 64; o <<= 1) v += __shfl_xor(v, o);
    return v;
}
__device__ __forceinline__ float wave_max(float v) {
#pragma unroll
    for (int o = 1; o < 64; o <<= 1) v = fmaxf(v, __shfl_xor(v, o));
    return v;
}
__device__ __forceinline__ float siluf(float x) { return x / (1.f + __expf(-x)); }
__device__ __forceinline__ float sigmf(float x) { return 1.f / (1.f + __expf(-x)); }
__device__ __forceinline__ float softplusf(float x) { return x > 20.f ? x : log1pf(__expf(x)); }

struct Frame {
    LAS unsigned char* lds;
    int tid, lane, wave, G, bid;
    float* out; unsigned char* ws;
};
__device__ __forceinline__ unsigned char* wsp(const Frame& F) { unsigned char* p = F.ws; asm volatile("" : "+s"(p)); return p; }
__device__ __forceinline__ LAS unsigned char* vlds(const Frame& F) { unsigned a = (unsigned)(__UINTPTR_TYPE__)F.lds; asm volatile("" : "+v"(a)); return (LAS unsigned char*)(__UINTPTR_TYPE__)a; }
constexpr int TAB_OFF = LDSCTL_OFF + 1024;
__device__ __forceinline__ const float* inp(const Frame& F, int i) {
    const unsigned long long v = ((const LAS unsigned long long*)(F.lds + TAB_OFF))[i];
    const unsigned lo = __builtin_amdgcn_readfirstlane((unsigned)v), hi = __builtin_amdgcn_readfirstlane((unsigned)(v >> 32));
    return (const float*)(((unsigned long long)hi << 32) | lo);
}
#define IN_XP 0
#define IN_XS 1
#define IN_SCONV 2
#define IN_SSSM 3
#define IN_CK 4
#define IN_CV 5
#define IN_CP 6
#define IN_CS 7
#define IN_GPREM 8
#define IN_GPOSTM 9
#define IN_GPREF 10
#define IN_GPOSTF 11
#define IN_WADA 12
#define IN_BADA 13
#define IN_WIN 14
#define IN_CONVW 15
#define IN_ALOG 16
#define IN_DTB 17
#define IN_GDNW 18
#define IN_SINKS 19
#define IN_WO 20
#define IN_WUP 21
#define IN_WDN 22

template <int MAPKIND  >
__device__ __forceinline__ void p0_transpose_item(const float* W, int K, int N, int Ndst, bf16* WT, LAS float* scr, int item, int lane) {
    const int nblk = Ndst / 32, kb = item / nblk, nb = item % nblk, k0 = 64 * kb, n0 = 32 * nb;
    const int nd = n0 + (lane & 31);
    int ns = nd;
    if (MAPKIND == 1) { ns = nd < 2048 ? nd : (nd < 2816 ? nd + 8 : (nd < 2824 ? nd - 768 : -1)); }
#pragma unroll 8
    for (int i = 0; i < 32; ++i) { const int kk = 2 * i + (lane >> 5); scr[kk * 33 + (lane & 31)] = (ns >= 0) ? W[(size_t)(k0 + kk) * N + ns] : 0.f; }
    LDS_WAIT(); asm volatile("" ::: "memory");
    const int c = lane & 7;
#pragma unroll
    for (int j = 0; j < 4; ++j) { const int n = (lane >> 3) + 8 * j; const LAS float* s = scr + (8 * c) * 33 + n;
        v4u o; o.x = pk2(s[0 * 33], s[1 * 33]); o.y = pk2(s[2 * 33], s[3 * 33]); o.z = pk2(s[4 * 33], s[5 * 33]); o.w = pk2(s[6 * 33], s[7 * 33]);
        *(GAS v4u*)(WT + (size_t)(n0 + n) * K + k0 + 8 * c) = o; }
    LDS_WAIT(); asm volatile("" ::: "memory");
}

__device__ __forceinline__ void p0_prologue(Frame& F) {
    LAS float* scr = (LAS float*)(F.lds + RING_OFF + F.wave * 16384);
    const int gw = F.bid * NWAVES + F.wave, NGW = F.G * NWAVES;
    constexpr int I_IN = (D / 64) * (NPROJ / 32), I_O = (D / 64) * (D / 32), I_UP = (D / 64) * (FF / 32), I_DN = (FF / 64) * (D / 32), I_ADA = (D / 64) * (NMOD / 32);
    constexpr int PER_L = I_IN + I_O + I_UP + I_DN + I_ADA;
    for (int it = gw; it < DEPTH * PER_L; it += NGW) {
        const int l = it / PER_L; int r = it % PER_L;
        if (r < I_IN) { p0_transpose_item<1>(inp(F, IN_WIN) + (size_t)l * D * NPROJ_REAL, D, NPROJ_REAL, NPROJ, (bf16*)(wsp(F) + WS_WIN) + (size_t)l * NPROJ * D, scr, r, F.lane); continue; } r -= I_IN;
        if (r < I_O) { p0_transpose_item<0>(inp(F, IN_WO) + (size_t)l * D * D, D, D, D, (bf16*)(wsp(F) + WS_WO) + (size_t)l * D * D, scr, r, F.lane); continue; } r -= I_O;
        if (r < I_UP) { p0_transpose_item<0>(inp(F, IN_WUP) + (size_t)l * D * FF, D, FF, FF, (bf16*)(wsp(F) + WS_WUP) + (size_t)l * FF * D, scr, r, F.lane); continue; } r -= I_UP;
        if (r < I_DN) { p0_transpose_item<0>(inp(F, IN_WDN) + (size_t)l * FF * D, FF, D, D, (bf16*)(wsp(F) + WS_WDN) + (size_t)l * D * FF, scr, r, F.lane); continue; } r -= I_DN;
        p0_transpose_item<0>(inp(F, IN_WADA) + (size_t)l * D * NMOD, D, NMOD, NMOD, (bf16*)(wsp(F) + WS_WADA) + (size_t)l * NMOD * D, scr, r, F.lane);
    }
    bf16* SC = (bf16*)(wsp(F) + WS_SC);
    for (int i = F.bid * NTHR + F.tid; i < 256 * D; i += F.G * NTHR) {
        const int r = i >> 10, c = i & 1023; float v = 0.f;
        if (r < NB_P) v = siluf(inp(F, IN_CP)[r * D + c]); else if (r < NB_P + NB_S) v = siluf(inp(F, IN_CS)[(r - NB_P) * D + c]);
        SC[i] = (bf16)f2bf(v);
    }
}

__device__ __forceinline__ const float* modp(Frame& F, int row, int l, int j) {
    const int mrow = row < MP ? (row >> 12) : NB_P + ((row - MP) >> 2);
    return (const float*)(wsp(F) + WS_MOD) + (size_t)mrow * (DEPTH * NMOD) + l * NMOD + j * D;
}
__device__ __forceinline__ void modnorm_store(Frame& F, const f32x4 (&v)[4], const float* g, const float* scale, const float* shift, bf16* orow) {
    float s = 0.f;
#pragma unroll
    for (int j = 0; j < 4; ++j) s += (v[j].x * v[j].x + v[j].y * v[j].y) + (v[j].z * v[j].z + v[j].w * v[j].w);
    const float rs = 1.0f / sqrtf(wave_sum(s) * (1.f / D) + EPS);
    GAS unsigned long long* o8 = (GAS unsigned long long*)orow + F.lane;
#pragma unroll
    for (int j = 0; j < 4; ++j) {
        const f32x4 gg = ((const f32x4*)g)[F.lane + 64 * j], sc = ((const f32x4*)scale)[F.lane + 64 * j], sh = ((const f32x4*)shift)[F.lane + 64 * j];
        const f32x4 h = (v[j] * rs) * gg * (sc + 1.0f) + sh;
        o8[64 * j] = (unsigned long long)pk2(h.x, h.y) | ((unsigned long long)pk2(h.z, h.w) << 32);
    }
}
__device__ __forceinline__ const float* xin_row(Frame& F, int row) { return row < MP ? inp(F, IN_XP) + (size_t)row * D : inp(F, IN_XS) + (size_t)(row - MP) * D; }
__device__ __forceinline__ void rowpass0(Frame& F) {
    const int gw = F.bid * NWAVES + F.wave, NGW = F.G * NWAVES;
    for (int row = gw; row < M; row += NGW) {
        const f32x4* xr = (const f32x4*)xin_row(F, row) + F.lane; f32x4 v[4];
#pragma unroll
        for (int j = 0; j < 4; ++j) v[j] = xr[64 * j];
        modnorm_store(F, v, inp(F, IN_GPREM), modp(F, row, 0, 1), modp(F, row, 0, 0), (bf16*)(wsp(F) + WS_XN) + (size_t)row * D);
    }
}
__device__ __forceinline__ void rowpass12(Frame& F, int l, int kind) {
    const int gw = F.bid * NWAVES + F.wave, NGW = F.G * NWAVES;
    float* X = (float*)(wsp(F) + WS_X); const float* MIX = (const float*)(wsp(F) + WS_MIX);
    for (int row = gw; row < M; row += NGW) {
        const float* xsrc = (l == 0 && kind == 1) ? xin_row(F, row) : X + (size_t)row * D;
        const f32x4* xr = (const f32x4*)xsrc + F.lane; const f32x4* mr = (const f32x4*)(MIX + (size_t)row * D) + F.lane;
        f32x4 x[4], m[4]; float s = 0.f;
#pragma unroll
        for (int j = 0; j < 4; ++j) { x[j] = xr[64 * j]; m[j] = mr[64 * j]; s += (m[j].x * m[j].x + m[j].y * m[j].y) + (m[j].z * m[j].z + m[j].w * m[j].w); }
        const float rs = 1.0f / sqrtf(wave_sum(s) * (1.f / D) + EPS);
        const float* gpost = inp(F, kind == 1 ? IN_GPOSTM : IN_GPOSTF) + l * D; const float* gate = modp(F, row, l, kind == 1 ? 2 : 5);
#pragma unroll
        for (int j = 0; j < 4; ++j) { const f32x4 gp = ((const f32x4*)gpost)[F.lane + 64 * j], gt = ((const f32x4*)gate)[F.lane + 64 * j]; x[j] = x[j] + gt * ((m[j] * rs) * gp); }
        const bool fin = (kind == 2 && l == DEPTH - 1);
        float* xdst = fin ? (row < MP ? F.out + OY_P + (size_t)row * D : F.out + OY_S + (size_t)(row - MP) * D) : X + (size_t)row * D;
#pragma unroll
        for (int j = 0; j < 4; ++j) ((f32x4*)xdst)[F.lane + 64 * j] = x[j];
        if (!fin) {
            if (kind == 1) modnorm_store(F, x, inp(F, IN_GPREF) + l * D, modp(F, row, l, 4), modp(F, row, l, 3), (bf16*)(wsp(F) + WS_XN) + (size_t)row * D);
            else modnorm_store(F, x, inp(F, IN_GPREM) + (l + 1) * D, modp(F, row, l + 1, 1), modp(F, row, l + 1, 0), (bf16*)(wsp(F) + WS_XN) + (size_t)row * D);
        }
    }
}

typedef short bf16x8 __attribute__((ext_vector_type(8)));
typedef float f32x16 __attribute__((ext_vector_type(16)));
typedef float f32x2_t __attribute__((ext_vector_type(2))); typedef __bf16 bf16x2_t __attribute__((ext_vector_type(2)));
typedef unsigned v2u __attribute__((ext_vector_type(2)));
#define MFMA32(a, b, c) __builtin_amdgcn_mfma_f32_32x32x16_bf16((a), (b), (c), 0, 0, 0)
__device__ __forceinline__ unsigned cvtpk(float lo, float hi) { f32x2_t v = {lo, hi}; bf16x2_t b = __builtin_convertvector(v, bf16x2_t); return __builtin_bit_cast(unsigned, b); }
__device__ __forceinline__ int crow(int i, int h) { return (i & 3) + 8 * (i >> 2) + 4 * h; }
__device__ __forceinline__ bf16x8 pack8(const f32x16& x, int s, float sc) {
    v4u p; p.x = cvtpk(x[8 * s] * sc, x[8 * s + 1] * sc); p.y = cvtpk(x[8 * s + 2] * sc, x[8 * s + 3] * sc); p.z = cvtpk(x[8 * s + 4] * sc, x[8 * s + 5] * sc); p.w = cvtpk(x[8 * s + 6] * sc, x[8 * s + 7] * sc);
    return __builtin_bit_cast(bf16x8, p);
}
constexpr size_t WS_GDN = 353 * MiB;
constexpr int GDN_CH_BYTES = 73728, GDN_STAGE_BYTES = 57344;
constexpr int GO_NW = 0, GO_QG = 16384, GO_KGT = 32768, GO_ATT = 49152, GO_U = 57344;
constexpr size_t WS_GL = WS_GDN + (size_t)1024 * GDN_CH_BYTES;
static_assert(WS_GL + 4096 <= WS_END, "gdn region");
constexpr int PL_KN = 0, PL_QN = 17408, PL_KBGT = 34816, PL_VBT = 53248, PL_KGT = 71680, PL_QG = 89088, PL_L = 105984, PL_T = 122368, PL_VEC = SCR_OFF;
static_assert(PL_T + 64 * 144 <= SCR_OFF, "prep lds");

__device__ __forceinline__ void gdn_prep_unit(Frame& F, int l, int unit) {
    const int b = unit >> 8, h = (unit >> 6) & 3, c = unit & 63, t0 = c * 64, R0 = b * SEQ + t0;
    int tid_ = F.tid; asm volatile("" : "+v"(tid_));
    const int tid = tid_, lane = tid & 63, wave = F.wave, r = lane & 31, hh = lane >> 5;
    const bf16* PROJ = (const bf16*)(wsp(F) + WS_PROJ);
    unsigned char* gout = wsp(F) + WS_GDN + (size_t)unit * GDN_CH_BYTES;
    LAS unsigned char* lds = vlds(F);
    LAS float* VEC = (LAS float*)(lds + PL_VEC);
    __syncthreads();
    if (wave == 0) {
        const bf16* prow = PROJ + (size_t)(R0 + lane) * NPROJ;
        const float bl = bf2f(prow[PC_BLG + h]), al = bf2f(prow[PC_ALG + h]);
        float g = -__expf(inp(F, IN_ALOG)[l * 4 + h]) * softplusf(al + inp(F, IN_DTB)[l * 4 + h]);
#pragma unroll
        for (int o = 1; o < 64; o <<= 1) { const float v = __shfl_up(g, o); if (lane >= o) g += v; }
        const float glast = __shfl(g, 63);
        VEC[lane] = g; VEC[64 + lane] = sigmf(bl); VEC[128 + lane] = __expf(g); VEC[192 + lane] = __expf(glast - g);
        if (lane == 0) ((float*)(wsp(F) + WS_GL))[unit] = __expf(glast);
    }
    __syncthreads();
    {
        const int t = tid >> 3, d0 = (tid & 7) * 16;
        const float beta = VEC[64 + t], eg = VEC[128 + t], ek = VEC[192 + t];
        const float* cwb = inp(F, IN_CONVW) + (size_t)l * 4 * CONVCH;
#pragma unroll 1
        for (int m = 0; m < 3; ++m) {
            const int col = m * 512 + h * 128 + d0;
            float acc[16], xl[16];
#pragma unroll
            for (int e = 0; e < 16; ++e) { acc[e] = 0.f; xl[e] = 0.f; }
#pragma unroll
            for (int i = 0; i < 4; ++i) {
                const int tt = t0 + t - 3 + i;
                v4u w0 = (v4u){0u, 0u, 0u, 0u}, w1 = w0;
                if (tt >= 0) { const v4u* p = (const v4u*)(PROJ + (size_t)(b * SEQ + tt) * NPROJ + col); w0 = p[0]; w1 = p[1]; }
                const f32x4* cp = (const f32x4*)(cwb + i * CONVCH + col);
                const f32x4 c0 = cp[0], c1 = cp[1], c2 = cp[2], c3 = cp[3];
                float x[16];
                x[0] = bflo(w0.x); x[1] = bfhi(w0.x); x[2] = bflo(w0.y); x[3] = bfhi(w0.y); x[4] = bflo(w0.z); x[5] = bfhi(w0.z); x[6] = bflo(w0.w); x[7] = bfhi(w0.w);
                x[8] = bflo(w1.x); x[9] = bfhi(w1.x); x[10] = bflo(w1.y); x[11] = bfhi(w1.y); x[12] = bflo(w1.z); x[13] = bfhi(w1.z); x[14] = bflo(w1.w); x[15] = bfhi(w1.w);
                acc[0] += c0.x * x[0]; acc[1] += c0.y * x[1]; acc[2] += c0.z * x[2]; acc[3] += c0.w * x[3];
                acc[4] += c1.x * x[4]; acc[5] += c1.y * x[5]; acc[6] += c1.z * x[6]; acc[7] += c1.w * x[7];
                acc[8] += c2.x * x[8]; acc[9] += c2.y * x[9]; acc[10] += c2.z * x[10]; acc[11] += c2.w * x[11];
                acc[12] += c3.x * x[12]; acc[13] += c3.y * x[13]; acc[14] += c3.z * x[14]; acc[15] += c3.w * x[15];
                if (i == 3) {
#pragma unroll
                    for (int e = 0; e < 16; ++e) xl[e] = x[e];
                }
            }
            if (c == 63 && t >= 61) {
                float* co = F.out + OCONV_P + ((size_t)(l * NB_P + b) * 3 + (t - 61)) * CONVCH + col;
#pragma unroll
                for (int e = 0; e < 16; ++e) co[e] = xl[e];
            }
            float ss = 0.f;
#pragma unroll
            for (int e = 0; e < 16; ++e) { acc[e] = siluf(acc[e]); ss += acc[e] * acc[e]; }
            ss += __shfl_xor(ss, 1); ss += __shfl_xor(ss, 2); ss += __shfl_xor(ss, 4);
            const float rs = 1.0f / sqrtf(ss + EPS);
            if (m == 0) {
                const float sq = rs * 0.08838834764831845f, sg = sq * eg;
                v4u a0, a1, g0, g1;
                a0.x = cvtpk(acc[0] * sq, acc[1] * sq); a0.y = cvtpk(acc[2] * sq, acc[3] * sq); a0.z = cvtpk(acc[4] * sq, acc[5] * sq); a0.w = cvtpk(acc[6] * sq, acc[7] * sq);
                a1.x = cvtpk(acc[8] * sq, acc[9] * sq); a1.y = cvtpk(acc[10] * sq, acc[11] * sq); a1.z = cvtpk(acc[12] * sq, acc[13] * sq); a1.w = cvtpk(acc[14] * sq, acc[15] * sq);
                g0.x = cvtpk(acc[0] * sg, acc[1] * sg); g0.y = cvtpk(acc[2] * sg, acc[3] * sg); g0.z = cvtpk(acc[4] * sg, acc[5] * sg); g0.w = cvtpk(acc[6] * sg, acc[7] * sg);
                g1.x = cvtpk(acc[8] * sg, acc[9] * sg); g1.y = cvtpk(acc[10] * sg, acc[11] * sg); g1.z = cvtpk(acc[12] * sg, acc[13] * sg); g1.w = cvtpk(acc[14] * sg, acc[15] * sg);
                *(LAS v4u*)(lds + PL_QN + t * 272 + d0 * 2) = a0; *(LAS v4u*)(lds + PL_QN + t * 272 + d0 * 2 + 16) = a1;
                *(LAS v2u*)(lds + PL_QG + t * 264 + d0 * 2) = (v2u){g0.x, g0.y}; *(LAS v2u*)(lds + PL_QG + t * 264 + d0 * 2 + 8) = (v2u){g0.z, g0.w};
                *(LAS v2u*)(lds + PL_QG + t * 264 + d0 * 2 + 16) = (v2u){g1.x, g1.y}; *(LAS v2u*)(lds + PL_QG + t * 264 + d0 * 2 + 24) = (v2u){g1.z, g1.w};
            } else if (m == 1) {
                v4u a0, a1;
                a0.x = cvtpk(acc[0] * rs, acc[1] * rs); a0.y = cvtpk(acc[2] * rs, acc[3] * rs); a0.z = cvtpk(acc[4] * rs, acc[5] * rs); a0.w = cvtpk(acc[6] * rs, acc[7] * rs);
                a1.x = cvtpk(acc[8] * rs, acc[9] * rs); a1.y = cvtpk(acc[10] * rs, acc[11] * rs); a1.z = cvtpk(acc[12] * rs, acc[13] * rs); a1.w = cvtpk(acc[14] * rs, acc[15] * rs);
                *(LAS v4u*)(lds + PL_KN + t * 272 + d0 * 2) = a0; *(LAS v4u*)(lds + PL_KN + t * 272 + d0 * 2 + 16) = a1;
                const float sb = rs * beta * eg, sk = rs * ek;
#pragma unroll
                for (int e = 0; e < 16; ++e) {
                    *(LAS bf16*)(lds + PL_KBGT + (d0 + e) * 144 + t * 2) = (bf16)f2bf(acc[e] * sb);
                    *(LAS bf16*)(lds + PL_KGT + (d0 + e) * 136 + t * 2) = (bf16)f2bf(acc[e] * sk);
                }
            } else {
#pragma unroll
                for (int e = 0; e < 16; ++e) *(LAS bf16*)(lds + PL_VBT + (d0 + e) * 144 + t * 2) = (bf16)f2bf(acc[e] * beta);
            }
        }
    }
    __syncthreads();
    if (wave < 6) {
        const bool isqk = wave >= 3; const int tsel = isqk ? wave - 3 : wave;
        const int ta = isqk ? (tsel == 2 ? 1 : 0) : (tsel == 0 ? 0 : 1);
        const int tb = isqk ? (tsel == 0 ? 0 : 1) : (tsel == 2 ? 1 : 0);
        const int boff = isqk ? PL_QN : PL_KN;
        f32x16 acc;
#pragma unroll
        for (int i = 0; i < 16; ++i) acc[i] = 0.f;
#pragma unroll
        for (int s = 0; s < 8; ++s) {
            const bf16x8 a = *(const LAS bf16x8*)(lds + PL_KN + (32 * ta + r) * 272 + (16 * s + 8 * hh) * 2);
            const bf16x8 bb = *(const LAS bf16x8*)(lds + boff + (32 * tb + r) * 272 + (16 * s + 8 * hh) * 2);
            acc = MFMA32(a, bb, acc);
        }
        if (!isqk) {
            const int j = 32 * tb + r; const float gj = VEC[j];
#pragma unroll
            for (int i2 = 0; i2 < 16; ++i2) { const int i = 32 * ta + crow(i2, hh);
                const float v = (i > j) ? VEC[64 + i] * acc[i2] * __expf(fminf(VEC[i] - gj, 0.f)) : 0.f;
                ((LAS float*)(lds + PL_L))[i * 64 + j] = v; }
        } else {
            const int cq = 32 * tb + r; const float gq = VEC[cq];
#pragma unroll
            for (int i2 = 0; i2 < 16; ++i2) { const int cp = 32 * ta + crow(i2, hh);
                acc[i2] = (cq >= cp) ? acc[i2] * __expf(fminf(gq - VEC[cp], 0.f)) : 0.f; }
#pragma unroll
            for (int s = 0; s < 2; ++s) *(v4u*)(gout + GO_ATT + ((tb * 4 + 2 * ta + s) * 64 + lane) * 16) = __builtin_bit_cast(v4u, pack8(acc, s, 1.f));
        }
    } else if (wave == 6) {
#pragma unroll
        for (int s = 0; s < 2; ++s) *(v4u*)(gout + GO_ATT + ((0 * 4 + 2 * 1 + s) * 64 + lane) * 16) = (v4u){0u, 0u, 0u, 0u};
    }
    __syncthreads();
    if (wave == 0) {
        float tc[64];
        const LAS float* Lm = (const LAS float*)(lds + PL_L);
#pragma unroll
        for (int i = 0; i < 64; ++i) {
            float a = (i == lane) ? 1.f : 0.f;
#pragma unroll
            for (int m = 0; m < i; ++m) a -= Lm[i * 64 + m] * tc[m];
            tc[i] = a;
        }
#pragma unroll
        for (int i = 0; i < 64; ++i) *(LAS bf16*)(lds + PL_T + i * 144 + lane * 2) = (bf16)f2bf(tc[i]);
    } else {
        for (int f = wave - 1; f < 32; f += 7) {
            if (f < 16) {
                const int ct = f >> 3, kk = f & 7, k0 = 32 * (kk >> 1) + 16 * (kk & 1) + 4 * hh;
                const v2u lo = *(const LAS v2u*)(lds + PL_QG + (32 * ct + r) * 264 + k0 * 2), hi = *(const LAS v2u*)(lds + PL_QG + (32 * ct + r) * 264 + (k0 + 8) * 2);
                *(v4u*)(gout + GO_QG + (f * 64 + lane) * 16) = (v4u){lo.x, lo.y, hi.x, hi.y};
            } else {
                const int g = f - 16, rt = g >> 2, k2 = g & 3, c0 = 32 * (k2 >> 1) + 16 * (k2 & 1) + 4 * hh;
                const v2u lo = *(const LAS v2u*)(lds + PL_KGT + (32 * rt + r) * 136 + c0 * 2), hi = *(const LAS v2u*)(lds + PL_KGT + (32 * rt + r) * 136 + (c0 + 8) * 2);
                *(v4u*)(gout + GO_KGT + (g * 64 + lane) * 16) = (v4u){lo.x, lo.y, hi.x, hi.y};
            }
        }
    }
    __syncthreads();
    {
        const int rt = wave >> 1, ct = wave & 1;
        f32x16 acc;
#pragma unroll
        for (int i = 0; i < 16; ++i) acc[i] = 0.f;
#pragma unroll
        for (int s = 0; s < 4; ++s) {
            const bf16x8 a = *(const LAS bf16x8*)(lds + PL_KBGT + (32 * rt + r) * 144 + (16 * s + 8 * hh) * 2);
            const bf16x8 bb = *(const LAS bf16x8*)(lds + PL_T + (32 * ct + r) * 144 + (16 * s + 8 * hh) * 2);
            acc = MFMA32(a, bb, acc);
        }
#pragma unroll
        for (int s = 0; s < 2; ++s) *(v4u*)(gout + GO_NW + ((ct * 8 + 2 * rt + s) * 64 + lane) * 16) = __builtin_bit_cast(v4u, pack8(acc, s, -1.f));
    }
    {
        const int ct = wave >> 2, wv = wave & 3;
        f32x16 acc;
#pragma unroll
        for (int i = 0; i < 16; ++i) acc[i] = 0.f;
#pragma unroll
        for (int s = 0; s < 4; ++s) {
            const bf16x8 a = *(const LAS bf16x8*)(lds + PL_T + (32 * ct + r) * 144 + (16 * s + 8 * hh) * 2);
            const bf16x8 bb = *(const LAS bf16x8*)(lds + PL_VBT + (32 * wv + r) * 144 + (16 * s + 8 * hh) * 2);
            acc = MFMA32(a, bb, acc);
        }
        v4u* up = (v4u*)(gout + GO_U + ((wv * 2 + ct) * 64 + lane) * 32);
        up[0] = __builtin_bit_cast(v4u, pack8(acc, 0, 1.f)); up[1] = __builtin_bit_cast(v4u, pack8(acc, 1, 1.f));
    }
}

constexpr int SL_STAGE1 = 57344, SL_O0 = 114688, SL_O1 = 131584, SL_OSTRIDE = 264;
static_assert(SL_O1 + 64 * SL_OSTRIDE <= CTL_LDS_OFF, "scan lds");

__device__ __forceinline__ void gdn_scan(Frame& F, int l, int bh) {
    const int b = bh >> 2, h = bh & 3;
    const int tid = F.tid, lane = F.lane, wave = F.wave, r = lane & 31, hh = lane >> 5;
    LAS unsigned char* lds = vlds(F);
    const unsigned char* gin = wsp(F) + WS_GDN + (size_t)(bh * 64) * GDN_CH_BYTES;
    __syncthreads();
    if (wave < 4) {
        const float* GLp = (const float*)(wsp(F) + WS_GL) + bh * 64;
        f32x16 S0, S1, S2, S3;
#pragma unroll
        for (int i = 0; i < 16; ++i) { S0[i] = 0.f; S1[i] = 0.f; S2[i] = 0.f; S3[i] = 0.f; }
        v4u u0a, u0b, u1a, u1b;
        { const v4u* up = (const v4u*)(gin + GO_U + ((wave * 2 + 0) * 64 + lane) * 32); u0a = up[0]; u0b = up[1]; const v4u* uq = (const v4u*)(gin + GO_U + ((wave * 2 + 1) * 64 + lane) * 32); u1a = uq[0]; u1b = uq[1]; }
        float gl = GLp[0];
        __syncthreads();
#pragma unroll 1
        for (int c = 0; c < 64; ++c) {
            LAS unsigned char* st = lds + (c & 1) * SL_STAGE1;
            f32x16 vn0, vn1, o0, o1;
            vn0[0] = bflo(u0a.x); vn0[1] = bfhi(u0a.x); vn0[2] = bflo(u0a.y); vn0[3] = bfhi(u0a.y); vn0[4] = bflo(u0a.z); vn0[5] = bfhi(u0a.z); vn0[6] = bflo(u0a.w); vn0[7] = bfhi(u0a.w);
            vn0[8] = bflo(u0b.x); vn0[9] = bfhi(u0b.x); vn0[10] = bflo(u0b.y); vn0[11] = bfhi(u0b.y); vn0[12] = bflo(u0b.z); vn0[13] = bfhi(u0b.z); vn0[14] = bflo(u0b.w); vn0[15] = bfhi(u0b.w);
            vn1[0] = bflo(u1a.x); vn1[1] = bfhi(u1a.x); vn1[2] = bflo(u1a.y); vn1[3] = bfhi(u1a.y); vn1[4] = bflo(u1a.z); vn1[5] = bfhi(u1a.z); vn1[6] = bflo(u1a.w); vn1[7] = bfhi(u1a.w);
            vn1[8] = bflo(u1b.x); vn1[9] = bfhi(u1b.x); vn1[10] = bflo(u1b.y); vn1[11] = bfhi(u1b.y); vn1[12] = bflo(u1b.z); vn1[13] = bfhi(u1b.z); vn1[14] = bflo(u1b.w); vn1[15] = bfhi(u1b.w);
#pragma unroll
            for (int i = 0; i < 16; ++i) { o0[i] = 0.f; o1[i] = 0.f; }
            const float glc = gl;
            if (c + 1 < 64) { const unsigned char* gn = gin + (size_t)(c + 1) * GDN_CH_BYTES;
                const v4u* up = (const v4u*)(gn + GO_U + ((wave * 2 + 0) * 64 + lane) * 32); u0a = up[0]; u0b = up[1];
                const v4u* uq = (const v4u*)(gn + GO_U + ((wave * 2 + 1) * 64 + lane) * 32); u1a = uq[0]; u1b = uq[1]; gl = GLp[c + 1]; }
#pragma unroll
            for (int kk = 0; kk < 8; ++kk) {
                const bf16x8 sb = pack8(kk < 2 ? S0 : (kk < 4 ? S1 : (kk < 6 ? S2 : S3)), kk & 1, 1.f);
                const bf16x8 a0 = *(const LAS bf16x8*)(st + GO_NW + ((0 * 8 + kk) * 64 + lane) * 16), a1 = *(const LAS bf16x8*)(st + GO_NW + ((1 * 8 + kk) * 64 + lane) * 16);
                const bf16x8 q0 = *(const LAS bf16x8*)(st + GO_QG + ((0 * 8 + kk) * 64 + lane) * 16), q1 = *(const LAS bf16x8*)(st + GO_QG + ((1 * 8 + kk) * 64 + lane) * 16);
                vn0 = MFMA32(a0, sb, vn0); vn1 = MFMA32(a1, sb, vn1);
                o0 = MFMA32(q0, sb, o0); o1 = MFMA32(q1, sb, o1);
            }
            bf16x8 vb[4];
            vb[0] = pack8(vn0, 0, 1.f); vb[1] = pack8(vn0, 1, 1.f); vb[2] = pack8(vn1, 0, 1.f); vb[3] = pack8(vn1, 1, 1.f);
#pragma unroll
            for (int i = 0; i < 16; ++i) { S0[i] *= glc; S1[i] *= glc; S2[i] *= glc; S3[i] *= glc; }
#pragma unroll
            for (int k2 = 0; k2 < 4; ++k2) {
                const bf16x8 t0 = *(const LAS bf16x8*)(st + GO_ATT + ((0 * 4 + k2) * 64 + lane) * 16), t1 = *(const LAS bf16x8*)(st + GO_ATT + ((1 * 4 + k2) * 64 + lane) * 16);
                o0 = MFMA32(t0, vb[k2], o0); o1 = MFMA32(t1, vb[k2], o1);
                const bf16x8 g0 = *(const LAS bf16x8*)(st + GO_KGT + ((0 * 4 + k2) * 64 + lane) * 16), g1 = *(const LAS bf16x8*)(st + GO_KGT + ((1 * 4 + k2) * 64 + lane) * 16);
                const bf16x8 g2 = *(const LAS bf16x8*)(st + GO_KGT + ((2 * 4 + k2) * 64 + lane) * 16), g3 = *(const LAS bf16x8*)(st + GO_KGT + ((3 * 4 + k2) * 64 + lane) * 16);
                S0 = MFMA32(g0, vb[k2], S0); S1 = MFMA32(g1, vb[k2], S1); S2 = MFMA32(g2, vb[k2], S2); S3 = MFMA32(g3, vb[k2], S3);
            }
            LAS unsigned char* ot = lds + ((c & 1) ? SL_O1 : SL_O0) + (32 * wave + r) * 2;
#pragma unroll
            for (int i = 0; i < 16; ++i) { *(LAS bf16*)(ot + crow(i, hh) * SL_OSTRIDE) = (bf16)f2bf(o0[i]); *(LAS bf16*)(ot + (32 + crow(i, hh)) * SL_OSTRIDE) = (bf16)f2bf(o1[i]); }
            __syncthreads();
        }
        __syncthreads();
        float* so = F.out + OSSM_P + ((size_t)(l * NB_P + b) * 4 + h) * 16384 + 32 * wave + r;
#pragma unroll
        for (int i = 0; i < 16; ++i) { so[(0 + crow(i, hh)) * 128] = S0[i]; so[(32 + crow(i, hh)) * 128] = S1[i]; so[(64 + crow(i, hh)) * 128] = S2[i]; so[(96 + crow(i, hh)) * 128] = S3[i]; }
    } else {
        const int lt = tid - 256;
        const bf16* PROJ = (const bf16*)(wsp(F) + WS_PROJ); bf16* O = (bf16*)(wsp(F) + WS_O);
        const int orow = lt >> 2, oq = lt & 3;
        float gw[32];
        { const float* gp = inp(F, IN_GDNW) + l * 128 + oq * 32;
#pragma unroll
          for (int e = 0; e < 32; ++e) gw[e] = gp[e]; }
        { const v4u* src = (const v4u*)gin + lt; v4u tmp[14];
#pragma unroll
          for (int j = 0; j < 14; ++j) tmp[j] = src[j * 256];
#pragma unroll
          for (int j = 0; j < 14; ++j) *(LAS v4u*)(lds + (j * 256 + lt) * 16) = tmp[j]; }
        __syncthreads();
#pragma unroll 1
        for (int c = 0; c <= 64; ++c) {
            if (c + 1 < 64) {
                const v4u* src = (const v4u*)(gin + (size_t)(c + 1) * GDN_CH_BYTES) + lt; LAS unsigned char* dst = lds + ((c + 1) & 1) * SL_STAGE1; v4u tmp[14];
#pragma unroll
                for (int j = 0; j < 14; ++j) tmp[j] = src[j * 256];
#pragma unroll
                for (int j = 0; j < 14; ++j) *(LAS v4u*)(dst + (j * 256 + lt) * 16) = tmp[j];
            }
            if (c >= 1) {
                const int cc = c - 1; const LAS unsigned char* ot = lds + ((cc & 1) ? SL_O1 : SL_O0) + orow * SL_OSTRIDE + oq * 64;
                const size_t row = (size_t)(b * SEQ + cc * 64 + orow);
                float ov[32]; float ss = 0.f;
#pragma unroll
                for (int j = 0; j < 8; ++j) { const v2u w = *(const LAS v2u*)(ot + j * 8); ov[4 * j] = bflo(w.x); ov[4 * j + 1] = bfhi(w.x); ov[4 * j + 2] = bflo(w.y); ov[4 * j + 3] = bfhi(w.y); }
#pragma unroll
                for (int e = 0; e < 32; ++e) ss += ov[e] * ov[e];
                ss += __shfl_xor(ss, 1); ss += __shfl_xor(ss, 2);
                const float rn = 1.0f / sqrtf(ss * (1.f / 128.f) + EPS);
                const v4u* zp = (const v4u*)(PROJ + row * NPROJ + PC_Z + h * 128 + oq * 32);
                v4u* op = (v4u*)(O + row * D + h * 128 + oq * 32);
#pragma unroll
                for (int j = 0; j < 4; ++j) { const v4u zw = zp[j]; float z[8];
                    z[0] = bflo(zw.x); z[1] = bfhi(zw.x); z[2] = bflo(zw.y); z[3] = bfhi(zw.y); z[4] = bflo(zw.z); z[5] = bfhi(zw.z); z[6] = bflo(zw.w); z[7] = bfhi(zw.w);
                    float y[8];
#pragma unroll
                    for (int e = 0; e < 8; ++e) y[e] = ov[8 * j + e] * rn * gw[8 * j + e] * siluf(z[e]);
                    v4u ow; ow.x = cvtpk(y[0], y[1]); ow.y = cvtpk(y[2], y[3]); ow.z = cvtpk(y[4], y[5]); ow.w = cvtpk(y[6], y[7]);
                    op[j] = ow; }
            }
            if (c < 64) __syncthreads();
        }
        __syncthreads();
    }
}

__device__ __forceinline__ void gdn_naive_item(Frame& F, int l, int row0, int T, int h, const float* S0, const float* cbuf, float* Sout, float* convout) {
    LAS float* sm = (LAS float*)(F.lds + RING_OFF);
    LAS float* red = sm + 384; LAS float* red2 = sm + 896; LAS float* part = sm + 1408; LAS float* part2 = sm + 1416; LAS float* scal = sm + 1424;
    const int tid = F.tid, v = tid & 127, kq = tid >> 7;
    const bf16* PROJ = (const bf16*)(wsp(F) + WS_PROJ); bf16* O = (bf16*)(wsp(F) + WS_O);
    float S[32];
#pragma unroll
    for (int i = 0; i < 32; ++i) S[i] = S0 ? S0[(kq * 32 + i) * 128 + v] : 0.f;
    float x1 = 0.f, x2 = 0.f, x3 = 0.f, cw0 = 0.f, cw1 = 0.f, cw2 = 0.f, cw3 = 0.f; int ch = 0;
    if (tid < 384) {
        ch = (tid >> 7) * 512 + h * 128 + (tid & 127);
        const float* cw = inp(F, IN_CONVW) + (size_t)l * 4 * CONVCH;
        cw0 = cw[ch]; cw1 = cw[CONVCH + ch]; cw2 = cw[2 * CONVCH + ch]; cw3 = cw[3 * CONVCH + ch];
        if (cbuf) { x1 = cbuf[ch]; x2 = cbuf[CONVCH + ch]; x3 = cbuf[2 * CONVCH + ch]; }
    }
    const float Aexp = __expf(inp(F, IN_ALOG)[l * 4 + h]), dtb = inp(F, IN_DTB)[l * 4 + h];
    const float gw = inp(F, IN_GDNW)[l * 128 + v];
    __syncthreads();
    for (int t = 0; t < T; ++t) {
        const size_t row = (size_t)(row0 + t); const bf16* prow = PROJ + row * NPROJ;
        if (tid < 384) {
            const float x = bf2f(prow[ch]);
            const float a = cw0 * x1 + cw1 * x2 + cw2 * x3 + cw3 * x; x1 = x2; x2 = x3; x3 = x;
            const float xc = siluf(a); sm[tid] = xc;
            const float ss = wave_sum(xc * xc); if (F.lane == 0) part[F.wave] = ss;
        }
        if (tid == 384) {
            const float bl = bf2f(prow[PC_BLG + h]), al = bf2f(prow[PC_ALG + h]);
            scal[0] = sigmf(bl); scal[1] = __expf(-Aexp * softplusf(al + dtb));
        }
        __syncthreads();
        const float rq = (1.0f / sqrtf(part[0] + part[1] + EPS)) * 0.08838834764831845f, rk = 1.0f / sqrtf(part[2] + part[3] + EPS);
        const float beta = scal[0], a = scal[1];
        float p = 0.f;
#pragma unroll
        for (int i = 0; i < 32; ++i) { S[i] *= a; p += S[i] * (sm[128 + kq * 32 + i] * rk); }
        red[kq * 128 + v] = p;
        __syncthreads();
        const float tot = (red[v] + red[128 + v]) + (red[256 + v] + red[384 + v]);
        const float coef = beta * (sm[256 + v] - tot);
        float op = 0.f;
#pragma unroll
        for (int i = 0; i < 32; ++i) { S[i] += (sm[128 + kq * 32 + i] * rk) * coef; op += S[i] * (sm[kq * 32 + i] * rq); }
        red2[kq * 128 + v] = op;
        __syncthreads();
        float o = 0.f;
        if (tid < 128) { o = (red2[v] + red2[128 + v]) + (red2[256 + v] + red2[384 + v]); const float ss = wave_sum(o * o); if (F.lane == 0) part2[F.wave] = ss; }
        __syncthreads();
        if (tid < 128) {
            const float rn = 1.0f / sqrtf((part2[0] + part2[1]) * (1.f / 128.f) + EPS);
            const float z = bf2f(prow[PC_Z + h * 128 + v]);
            O[row * D + h * 128 + v] = (bf16)f2bf(o * rn * gw * siluf(z));
        }
    }
#pragma unroll
    for (int i = 0; i < 32; ++i) Sout[(kq * 32 + i) * 128 + v] = S[i];
    if (tid < 384) { convout[ch] = x1; convout[CONVCH + ch] = x2; convout[2 * CONVCH + ch] = x3; }
    __syncthreads();
}

__device__ __forceinline__ void swa_naive_item(Frame& F, int l, int row, int kvh) {
    LAS float* scw = (LAS float*)(F.lds + RING_OFF + 8192 + F.wave * 2048);
    const bf16* PROJ = (const bf16*)(wsp(F) + WS_PROJ); bf16* O = (bf16*)(wsp(F) + WS_O);
    const int lane = F.lane;
    const bool samp = row >= MP;
    const int b = samp ? (row - MP) >> 2 : row >> 12, t = samp ? (row - MP) & 3 : row & 4095;
    const int seq0 = samp ? MP + b * 4 : b * SEQ;
    const bf16* prow = PROJ + (size_t)row * NPROJ;
    float qv[4];
#pragma unroll
    for (int g = 0; g < 4; ++g) qv[g] = bf2f(prow[PC_QB + (kvh * 4 + g) * 64 + lane]);
    const float* ck = inp(F, IN_CK) + ((size_t)(l * NB_S + b) * 128) * 128 + kvh * 64;
    const float* cv = inp(F, IN_CV) + ((size_t)(l * NB_S + b) * 128) * 128 + kvh * 64;
#pragma unroll 2
    for (int ci = 0; ci < 128; ++ci) {
        float kv; bool valid = true;
        if (!samp) { int s = t - 127 + ci; valid = s >= 0; s = valid ? s : 0; kv = bf2f(PROJ[(size_t)(seq0 + s) * NPROJ + PC_KB + kvh * 64 + lane]); }
        else { const int cidx = t + 1 + ci; kv = cidx < 128 ? ck[(size_t)cidx * 128 + lane] : bf2f(PROJ[(size_t)(seq0 + cidx - 128) * NPROJ + PC_KB + kvh * 64 + lane]); }
#pragma unroll
        for (int g = 0; g < 4; ++g) { const float s = wave_sum(qv[g] * kv); if (lane == 0) scw[g * 128 + ci] = valid ? s * 0.125f : -INFINITY; }
    }
    LDS_WAIT(); asm volatile("" ::: "memory");
#pragma unroll
    for (int g = 0; g < 4; ++g) {
        const float sk = inp(F, IN_SINKS)[l * 8 + kvh * 4 + g];
        const float s0 = scw[g * 128 + lane], s1 = scw[g * 128 + 64 + lane];
        const float mx = fmaxf(wave_max(fmaxf(s0, s1)), sk);
        const float p0 = __expf(s0 - mx), p1 = __expf(s1 - mx);
        const float den = wave_sum(p0 + p1) + __expf(sk - mx);
        scw[g * 128 + lane] = p0 / den; scw[g * 128 + 64 + lane] = p1 / den;
    }
    LDS_WAIT(); asm volatile("" ::: "memory");
    float o[4] = {0.f, 0.f, 0.f, 0.f};
#pragma unroll 2
    for (int ci = 0; ci < 128; ++ci) {
        float vv;
        if (!samp) { int s = t - 127 + ci; s = s < 0 ? 0 : s; vv = bf2f(PROJ[(size_t)(seq0 + s) * NPROJ + PC_VB + kvh * 64 + lane]); }
        else { const int cidx = t + 1 + ci; vv = cidx < 128 ? cv[(size_t)cidx * 128 + lane] : bf2f(PROJ[(size_t)(seq0 + cidx - 128) * NPROJ + PC_VB + kvh * 64 + lane]); }
#pragma unroll
        for (int g = 0; g < 4; ++g) o[g] += scw[g * 128 + ci] * vv;
    }
#pragma unroll
    for (int g = 0; g < 4; ++g) O[(size_t)row * D + 512 + (kvh * 4 + g) * 64 + lane] = (bf16)f2bf(o[g]);
    LDS_WAIT(); asm volatile("" ::: "memory");
}

__device__ __forceinline__ void mixers_rest(Frame& F, int l) {
    const bf16* PROJ = (const bf16*)(wsp(F) + WS_PROJ);
    const int wg = F.bid - 16, nwg = F.G - 16;
    for (int it = wg; it < NB_S * 4; it += nwg) {
        const int b = it >> 2, h = it & 3;
        gdn_naive_item(F, l, MP + b * T_S, T_S, h, inp(F, IN_SSSM) + ((size_t)(l * NB_S + b) * 4 + h) * 16384, inp(F, IN_SCONV) + (size_t)(l * NB_S + b) * 3 * CONVCH,
                       F.out + OSSM_S + ((size_t)(l * NB_S + b) * 4 + h) * 16384, F.out + OCONV_S + (size_t)(l * NB_S + b) * 3 * CONVCH);
    }
    for (int it = wg * NWAVES + F.wave; it < M * 2; it += nwg * NWAVES) swa_naive_item(F, l, it >> 1, it & 1);
    const int gt = wg * NTHR + F.tid, ngt = nwg * NTHR;
    for (int i = gt; i < NB_P * 128 * 128; i += ngt) {
        const int b = i >> 14, j = (i >> 7) & 127, c = i & 127; const bf16* prow = PROJ + (size_t)(b * SEQ + SEQ - 128 + j) * NPROJ;
        F.out[OK_P + (size_t)l * NB_P * 16384 + i] = bf2f(prow[PC_KB + c]); F.out[OV_P + (size_t)l * NB_P * 16384 + i] = bf2f(prow[PC_VB + c]);
    }
    for (int i = gt; i < NB_S * 128 * 128; i += ngt) {
        const int b = i >> 14, j = (i >> 7) & 127, c = i & 127; float kk, vv;
        if (j < 124) { const size_t src = ((size_t)(l * NB_S + b) * 128 + j + 4) * 128 + c; kk = inp(F, IN_CK)[src]; vv = inp(F, IN_CV)[src]; }
        else { const bf16* prow = PROJ + (size_t)(MP + b * T_S + (j - 124)) * NPROJ; kk = bf2f(prow[PC_KB + c]); vv = bf2f(prow[PC_VB + c]); }
        F.out[OK_S + (size_t)l * NB_S * 16384 + i] = kk; F.out[OV_S + (size_t)l * NB_S * 16384 + i] = vv;
    }
}

struct Args { const float* in[23]; float* out; unsigned char* ws; int ph_lo, ph_hi; };
constexpr int NPH = 3 + 8 * DEPTH;

__global__ void __launch_bounds__(NTHR, 2) mega_fwd(Args args) {
    extern __shared__ __attribute__((aligned(16))) unsigned char lds[];
    Frame F;
    F.lds = (LAS unsigned char*)lds;
    F.tid = threadIdx.x; F.lane = F.tid & 63; F.wave = __builtin_amdgcn_readfirstlane(F.tid >> 6);
    F.G = gridDim.x; F.bid = blockIdx.x;
    if (F.tid < 23) ((LAS unsigned long long*)(F.lds + TAB_OFF))[F.tid] = (unsigned long long)args.in[F.tid];
    F.out = args.out; F.ws = args.ws;
    __syncthreads();
#if MK_ONE_LAUNCH
    cooperative_groups::grid_group grid = cooperative_groups::this_grid();
#endif
    for (int ph = args.ph_lo; ph < args.ph_hi; ++ph) {
        { int t_ = threadIdx.x; asm volatile("" : "+v"(t_)); F.tid = t_; F.lane = t_ & 63; F.wave = __builtin_amdgcn_readfirstlane(t_ >> 6);
          int b_ = blockIdx.x, g_ = gridDim.x; asm volatile("" : "+s"(b_), "+s"(g_)); F.bid = b_; F.G = g_; }
        int kind, l = 0;
        if (ph < 3) kind = ph; else { l = (ph - 3) / 8; kind = 3 + (ph - 3) % 8; }
        if (kind == 0) p0_prologue(F);
        else if (kind == 2) rowpass0(F);
        else if (kind == 4) { for (int u = F.bid; u < 1024; u += F.G) gdn_prep_unit(F, l, u); }
        else if (kind == 5) { if (F.bid < 16) gdn_scan(F, l, F.bid); else mixers_rest(F, l); }
        else if (kind == 7) rowpass12(F, l, 1);
        else if (kind == 10) rowpass12(F, l, 2);
        else if (kind == 3) {
            pg8::Gemm g{(const bf16*)(wsp(F) + WS_XN), (const bf16*)(wsp(F) + WS_WIN) + (size_t)l * NPROJ * D, M, NPROJ, D};
            pg8::StaticOrder S; S.init(M, NPROJ, F.G, F.bid);
            pg8::EpiBf16<0> E{(bf16*)(wsp(F) + WS_PROJ), NPROJ};
            pg8::gemm_phase<pg8::EpiBf16<0>, pg8::StaticOrder, PG8_ALIGN, PG8_SP2>(F.lds + RING_OFF, g, S, E, F.tid);
        } else if (kind == 8) {
            pg8::Gemm g{(const bf16*)(wsp(F) + WS_XN), (const bf16*)(wsp(F) + WS_WUP) + (size_t)l * FF * D, M, FF, D};
            pg8::StaticOrder S; S.init(M, FF, F.G, F.bid);
            pg8::EpiBf16<2> E{(bf16*)(wsp(F) + WS_H), FF};
            pg8::gemm_phase<pg8::EpiBf16<2>, pg8::StaticOrder, PG8_ALIGN, PG8_SP2>(F.lds + RING_OFF, g, S, E, F.tid);
        } else {
            pg8::Gemm g; pg8::EpiF32 E;
            if (kind == 1) { g = pg8::Gemm{(const bf16*)(wsp(F) + WS_SC), (const bf16*)(wsp(F) + WS_WADA), 256, DEPTH * NMOD, D}; E = pg8::EpiF32{(float*)(wsp(F) + WS_MOD), DEPTH * NMOD, inp(F, IN_BADA)}; }
            else if (kind == 6) { g = pg8::Gemm{(const bf16*)(wsp(F) + WS_O), (const bf16*)(wsp(F) + WS_WO) + (size_t)l * D * D, M, D, D}; E = pg8::EpiF32{(float*)(wsp(F) + WS_MIX), D, nullptr}; }
            else { g = pg8::Gemm{(const bf16*)(wsp(F) + WS_H), (const bf16*)(wsp(F) + WS_WDN) + (size_t)l * D * FF, M, D, FF}; E = pg8::EpiF32{(float*)(wsp(F) + WS_MIX), D, nullptr}; }
            pg8::StaticOrder S; S.init(g.M, g.N, F.G, F.bid);
            pg8::gemm_phase<pg8::EpiF32, pg8::StaticOrder, PG8_ALIGN, PG8_SP2>(F.lds + RING_OFF, g, S, E, F.tid);
        }
#if MK_ONE_LAUNCH
        if (ph + 1 < args.ph_hi) grid.sync();
#endif
    }
}

extern "C" void kernel_launch(void* const* d_in, const int* in_sizes, int n_in, void* d_out, int out_size, void* d_ws, size_t ws_size, hipStream_t stream) {
    static int grid = 0;
    if (grid == 0) {
        if (n_in != 23 || (size_t)out_size != OUT_TOTAL || ws_size < WS_END) { fprintf(stderr, "kernel_launch: unexpected shapes n_in %d out %d ws %zu\n", n_in, out_size, ws_size); grid = -1; return; }
        int dev = 0, cus = 0, per_cu = 0;
        if (hipGetDevice(&dev) != hipSuccess || hipDeviceGetAttribute(&cus, hipDeviceAttributeMultiprocessorCount, dev) != hipSuccess) { grid = -1; return; }
        if (hipFuncSetAttribute((const void*)mega_fwd, hipFuncAttributeMaxDynamicSharedMemorySize, LDS_BYTES) != hipSuccess) { fprintf(stderr, "kernel_launch: hipFuncSetAttribute failed\n"); grid = -1; return; }
        if (hipOccupancyMaxActiveBlocksPerMultiprocessor(&per_cu, (const void*)mega_fwd, NTHR, LDS_BYTES) != hipSuccess || per_cu < 1) { fprintf(stderr, "kernel_launch: occupancy query says %d\n", per_cu); per_cu = 1; }
        (void)hipGetLastError();
        grid = cus;
    }
    if (grid < 0) return;
    Args a{};
    for (int i = 0; i < 23; ++i) a.in[i] = (const float*)d_in[i];
    a.out = (float*)d_out; a.ws = (unsigned char*)d_ws;
#if MK_ONE_LAUNCH
    a.ph_lo = 0; a.ph_hi = NPH;
    void* kargs[] = {&a};
    hipError_t e = hipLaunchCooperativeKernel((const void*)mega_fwd, dim3(grid), dim3(NTHR), kargs, LDS_BYTES, stream);
    if (e != hipSuccess) fprintf(stderr, "cooperative launch failed: %s (grid %d)\n", hipGetErrorString(e), grid);
#else
    for (int ph = 0; ph < NPH; ++ph) {
        a.ph_lo = ph; a.ph_hi = ph + 1;
        hipLaunchKernelGGL(mega_fwd, dim3(grid), dim3(NTHR), LDS_BYTES, stream, a);
    }
#endif
}
```

```cpp
#include <hip/hip_runtime.h>
#include <hip/hip_cooperative_groups.h>
#include <cstdio>
#include <cstdint>
#include <cmath>
namespace pg8 {
#define PG8_LAS __attribute__((address_space(3)))
typedef unsigned short bf16_t;
typedef short bf16x8 __attribute__((ext_vector_type(8)));
typedef float f32x4 __attribute__((ext_vector_type(4)));
typedef unsigned u32x4 __attribute__((ext_vector_type(4)));
constexpr int BM = 256, BK = 64, HALF = 128, HTB = HALF * BK * 2  , STAGE_BYTES = 8 * HTB, NXCD = 8, WGM = 8;

__host__ __device__ __forceinline__ int lds_byte(int r, int c) { const int st = (r >> 4) * 2 + (c >> 5), rr = r & 15, cc = c & 31, ob = rr * 64 + cc * 2; return st * 1024 + (ob ^ (((ob >> 9) & 1) << 5)); }
__host__ __device__ __forceinline__ void stage_rc(int b, int& R, int& C) { const int st = b / 1024, sb = b % 1024, swz = sb ^ (((sb >> 9) & 1) << 5); R = (st >> 1) * 16 + swz / 64; C = (st & 1) * 32 + (swz % 64) / 2; }
__host__ __device__ __forceinline__ int perm32(int rho) { const int n = rho >> 4, i = rho & 15; return 8 * (i >> 2) + 4 * n + (i & 3); }

struct Unit { int pm, pn; };
struct Gemm { const bf16_t* A; const bf16_t* Bt; int M, N, K; };

struct StaticOrder {
    int nM, nN, nwg, G, c;
    __host__ __device__ void init(int M, int N, int G_, int c_) { nM = M / BM; nN = N / BM; nwg = nM * nN; G = G_; c = c_; }
    __host__ __device__ bool next(int i, Unit& u) const {
        const long L = (long)i * G + c; if (L >= nwg) return false;
        int wgid = (int)L; { const int q = nwg / NXCD, r = nwg % NXCD, xcd = wgid % NXCD, off = wgid / NXCD; wgid = (xcd < r ? xcd * (q + 1) : r * (q + 1) + (xcd - r) * q) + off; }
        const int nig = WGM * nN, gid = wgid / nig, fm = gid * WGM, gsz = (nM - fm) < WGM ? (nM - fm) : WGM;
        u.pm = fm + ((wgid % nig) % gsz); u.pn = (wgid % nig) / gsz; return true;
    }
    __device__ __forceinline__ void a_ready(const Unit&) const {}
    __device__ __forceinline__ void done(const Unit&) const {}
};


__device__ __forceinline__ unsigned cvt_pk_bf16(float lo, float hi) { unsigned r; asm volatile("v_cvt_pk_bf16_f32 %0, %1, %2" : "=v"(r) : "v"(lo), "v"(hi)); return r; }
struct EpiF32 {
    static constexpr bool PERM = false, AFTER_DRAIN = false;
    float* C; int ldc; const float* bias;
    __device__ __forceinline__ void operator()(const f32x4 (&acc)[2][2][4][2], const Unit& u, int wr, int wc, int fr, int fq) const {
        const int row0 = u.pm * BM + wr * 64 + fr, col0 = u.pn * BM + wc * 32 + 4 * fq;
        f32x4 bv[2][2];
#pragma unroll
        for (int bj = 0; bj < 2; ++bj)
#pragma unroll
            for (int n = 0; n < 2; ++n) bv[bj][n] = bias ? *(const f32x4*)(bias + col0 + bj * HALF + n * 16) : (f32x4){0.f, 0.f, 0.f, 0.f};
#pragma unroll
        for (int ai = 0; ai < 2; ++ai)
#pragma unroll
            for (int m = 0; m < 4; ++m) { float* rowp = C + (size_t)(row0 + ai * HALF + m * 16) * ldc + col0;
#pragma unroll
                for (int bj = 0; bj < 2; ++bj)
#pragma unroll
                    for (int n = 0; n < 2; ++n) *(f32x4*)(rowp + bj * HALF + n * 16) = acc[ai][bj][m][n] + bv[bj][n]; }
    }
};
template <int ACT  > struct EpiBf16 {
    static constexpr bool PERM = true, AFTER_DRAIN = false;
    bf16_t* O; int ldc;
    __device__ __forceinline__ void operator()(const f32x4 (&acc)[2][2][4][2], const Unit& u, int wr, int wc, int fr, int fq) const {
        const int row0 = u.pm * BM + wr * 64 + fr; const int col0 = u.pn * BM + wc * 32 + 8 * fq;
#pragma unroll
        for (int ai = 0; ai < 2; ++ai)
#pragma unroll
            for (int m = 0; m < 4; ++m) { bf16_t* rowp = O + (size_t)(row0 + ai * HALF + m * 16) * ldc + col0;
#pragma unroll
                for (int bj = 0; bj < 2; ++bj) { f32x4 v0 = acc[ai][bj][m][0], v1 = acc[ai][bj][m][1];
                    if (ACT == 2) {
#pragma unroll
                        for (int e = 0; e < 4; ++e) { const float a = fmaxf(v0[e], 0.f), b = fmaxf(v1[e], 0.f); v0[e] = a * a; v1[e] = b * b; } }
                    u32x4 w; w.x = cvt_pk_bf16(v0[0], v0[1]); w.y = cvt_pk_bf16(v0[2], v0[3]); w.z = cvt_pk_bf16(v1[0], v1[1]); w.w = cvt_pk_bf16(v1[2], v1[3]);
                    *(u32x4*)(rowp + bj * HALF) = w; } }
    }
};

template <class Epi, class Sched, bool ALIGN_EPI = false, bool SP2 = false>
__device__ __forceinline__ void gemm_phase(PG8_LAS unsigned char* lds, const Gemm g, const Sched& S, const Epi& E, const int tid) {
    const int wid = __builtin_amdgcn_readfirstlane(tid >> 6), lane = tid & 63, wr = wid >> 2, wc = wid & 3, fr = lane & 15, fq = lane >> 4;
    const int K = g.K, nt = K / BK;
    unsigned voffA[2], voffB[2];
#pragma unroll
    for (int i = 0; i < 2; ++i) { int R, C; stage_rc(tid * 16 + i * 8192, R, C); const int Rb = Epi::PERM ? ((R & ~31) + perm32(R & 31)) : R;
        voffA[i] = (unsigned)(R * K + C) * 2u; voffB[i] = (unsigned)(Rb * K + C) * 2u; }
    const size_t kstep = (size_t)(BK * 2);
    const size_t hstep = (size_t)HALF * K * 2;
    const size_t tstep = 2 * hstep;
    const unsigned ldsw = (unsigned)wid * 1024u;
    const int aoff = lds_byte(wr * 64 + fr, fq * 8), boff = lds_byte(wc * 32 + fr, fq * 8);
#define PG8_SA(b, h) (((b) * 2 + (h)) * HTB)
#define PG8_SB(b, h) ((4 + (b) * 2 + (h)) * HTB)
#define PG8_STAGE(bufoff, gbase, voff) do { _Pragma("unroll") for (int _i = 0; _i < 2; ++_i) \
        __builtin_amdgcn_global_load_lds((const unsigned*)((const char*)(gbase) + (voff)[_i]), (PG8_LAS unsigned*)(lds + (bufoff) + ldsw + _i * 8192), 16, 0, 0); } while (0)
#define PG8_LDA(dst, b, h) do { _Pragma("unroll") for (int m = 0; m < 4; ++m) _Pragma("unroll") for (int k = 0; k < 2; ++k) dst[m][k] = *(const PG8_LAS bf16x8*)(lds + PG8_SA(b, h) + aoff + m * 2048 + k * 1024); } while (0)
#define PG8_LDB(dst, b, h) do { _Pragma("unroll") for (int n = 0; n < 2; ++n) _Pragma("unroll") for (int k = 0; k < 2; ++k) dst[n][k] = *(const PG8_LAS bf16x8*)(lds + PG8_SB(b, h) + boff + n * 2048 + k * 1024); } while (0)
#define PG8_MMA(ai, bj, At, Bt) do { __builtin_amdgcn_s_setprio(1); _Pragma("unroll") for (int m = 0; m < 4; ++m) _Pragma("unroll") for (int n = 0; n < 2; ++n) _Pragma("unroll") for (int k = 0; k < 2; ++k) \
        acc[ai][bj][m][n] = __builtin_amdgcn_mfma_f32_16x16x32_bf16(Bt[n][k], At[m][k], acc[ai][bj][m][n], 0, 0, 0); __builtin_amdgcn_s_setprio(0); } while (0)
#define PG8_WAIT_V(n) asm volatile("s_waitcnt vmcnt(" #n ")" ::: "memory")
#define PG8_WAIT_L(n) asm volatile("s_waitcnt lgkmcnt(" #n ")" ::: "memory")
#define PG8_BAR __builtin_amdgcn_s_barrier()
#define PG8_SCHED __builtin_amdgcn_sched_barrier(0)
    Unit cur, nxt; int ui = 0;
    if (!S.next(0, cur)) return;
    f32x4 acc[2][2][4][2];
#pragma unroll
    for (int a = 0; a < 2; ++a)
#pragma unroll
        for (int b = 0; b < 2; ++b)
#pragma unroll
            for (int m = 0; m < 4; ++m)
#pragma unroll
                for (int n = 0; n < 2; ++n) acc[a][b][m][n] = (f32x4){0.f, 0.f, 0.f, 0.f};
    bf16x8 At[4][2], B0[2][2], B1[2][2];
    const char* cA = (const char*)g.A + (size_t)cur.pm * tstep; const char* cB = (const char*)g.Bt + (size_t)cur.pn * tstep;
    S.a_ready(cur);
    if constexpr (SP2) {
        PG8_STAGE(PG8_SB(0, 0), cB, voffB); PG8_STAGE(PG8_SB(0, 1), cB + hstep, voffB); PG8_STAGE(PG8_SA(0, 0), cA, voffA); PG8_STAGE(PG8_SA(0, 1), cA + hstep, voffA);
        if (wr == 1) PG8_BAR;
        PG8_WAIT_V(2); PG8_BAR;
        PG8_STAGE(PG8_SB(1, 0), cB + kstep, voffB); PG8_STAGE(PG8_SA(1, 0), cA + kstep, voffA); PG8_STAGE(PG8_SB(1, 1), cB + hstep + kstep, voffB);
        PG8_WAIT_V(6); PG8_BAR;
    } else {
        PG8_STAGE(PG8_SB(0, 0), cB, voffB); PG8_STAGE(PG8_SA(0, 0), cA, voffA); PG8_STAGE(PG8_SB(0, 1), cB + hstep, voffB); PG8_STAGE(PG8_SA(0, 1), cA + hstep, voffA);
        if (wr == 1) PG8_BAR;
        PG8_WAIT_V(4); PG8_BAR;
        PG8_STAGE(PG8_SB(1, 0), cB + kstep, voffB); PG8_STAGE(PG8_SA(1, 0), cA + kstep, voffA); PG8_STAGE(PG8_SB(1, 1), cB + hstep + kstep, voffB);
        PG8_WAIT_V(6); PG8_BAR;
    }
    for (;;) {
        const bool has_next = S.next(ui + 1, nxt);
        const char* nA = has_next ? (const char*)g.A + (size_t)nxt.pm * tstep : cA; const char* nB = has_next ? (const char*)g.Bt + (size_t)nxt.pn * tstep : cB;
        for (int t = 0; t < nt; t += 2) {
            const bool last = (t == nt - 2);
            const char* a1 = cA + (size_t)(t + 1) * kstep;
            const char* a2 = last ? nA : cA + (size_t)(t + 2) * kstep; const char* b2 = last ? nB : cB + (size_t)(t + 2) * kstep;
            const char* a3 = a2 + kstep; const char* b3 = b2 + kstep;
            if (last && has_next) S.a_ready(nxt);
            if constexpr (SP2) {
            PG8_LDB(B0, 0, 0); PG8_LDB(B1, 0, 1); PG8_SCHED; PG8_LDA(At, 0, 0); PG8_STAGE(PG8_SA(1, 1), a1 + hstep, voffA);
            PG8_WAIT_V(8); PG8_WAIT_L(0); PG8_BAR; PG8_MMA(0, 0, At, B0); PG8_MMA(0, 1, At, B1); PG8_BAR; PG8_SCHED;
            PG8_LDA(At, 0, 1); PG8_STAGE(PG8_SB(0, 0), b2, voffB); PG8_STAGE(PG8_SB(0, 1), b2 + hstep, voffB); PG8_STAGE(PG8_SA(0, 0), a2, voffA);
            PG8_WAIT_V(8); PG8_WAIT_L(0); PG8_BAR; PG8_MMA(1, 0, At, B0); PG8_MMA(1, 1, At, B1); PG8_BAR; PG8_SCHED;
            PG8_LDB(B0, 1, 0); PG8_LDB(B1, 1, 1); PG8_SCHED; PG8_LDA(At, 1, 0); PG8_STAGE(PG8_SA(0, 1), a2 + hstep, voffA);
            PG8_WAIT_V(8); PG8_WAIT_L(0); PG8_BAR; PG8_MMA(0, 0, At, B0); PG8_MMA(0, 1, At, B1); PG8_BAR; PG8_SCHED;
            PG8_LDA(At, 1, 1); PG8_STAGE(PG8_SB(1, 0), b3, voffB); PG8_STAGE(PG8_SB(1, 1), b3 + hstep, voffB); PG8_STAGE(PG8_SA(1, 0), a3, voffA);
            PG8_WAIT_V(8); PG8_WAIT_L(0); PG8_BAR; PG8_MMA(1, 0, At, B0); PG8_MMA(1, 1, At, B1); PG8_BAR; PG8_SCHED;
            } else {
            PG8_LDB(B0, 0, 0); PG8_SCHED; PG8_LDA(At, 0, 0); PG8_STAGE(PG8_SA(1, 1), a1 + hstep, voffA);
            PG8_WAIT_L(8); PG8_BAR; PG8_WAIT_L(0); PG8_MMA(0, 0, At, B0); PG8_BAR; PG8_SCHED;
            PG8_LDB(B1, 0, 1); PG8_STAGE(PG8_SB(0, 0), b2, voffB);
            PG8_BAR; PG8_WAIT_L(0); PG8_MMA(0, 1, At, B1); PG8_BAR;
            PG8_LDA(At, 0, 1); PG8_STAGE(PG8_SA(0, 0), a2, voffA);
            PG8_BAR; PG8_WAIT_L(0); PG8_MMA(1, 0, At, B0); PG8_BAR; PG8_SCHED;
            PG8_STAGE(PG8_SB(0, 1), b2 + hstep, voffB);
            PG8_WAIT_V(6); PG8_BAR; PG8_MMA(1, 1, At, B1); PG8_BAR;
            PG8_LDB(B0, 1, 0); PG8_SCHED; PG8_LDA(At, 1, 0); PG8_STAGE(PG8_SA(0, 1), a2 + hstep, voffA);
            PG8_WAIT_L(8); PG8_BAR; PG8_WAIT_L(0); PG8_MMA(0, 0, At, B0); PG8_BAR; PG8_SCHED;
            PG8_LDB(B1, 1, 1); PG8_STAGE(PG8_SB(1, 0), b3, voffB);
            PG8_BAR; PG8_WAIT_L(0); PG8_MMA(0, 1, At, B1); PG8_BAR;
            PG8_LDA(At, 1, 1); PG8_STAGE(PG8_SA(1, 0), a3, voffA);
            PG8_BAR; PG8_WAIT_L(0); PG8_MMA(1, 0, At, B0); PG8_BAR; PG8_SCHED;
            PG8_STAGE(PG8_SB(1, 1), b3 + hstep, voffB);
            PG8_WAIT_V(6); PG8_BAR; PG8_MMA(1, 1, At, B1); PG8_BAR;
            }
        }
        if constexpr (ALIGN_EPI) { if (wr == 0) PG8_BAR; }
        if constexpr (!Epi::AFTER_DRAIN) { E(acc, cur, wr, wc, fr, fq); S.done(cur); }
        if (!has_next) break;
#pragma unroll
        for (int a = 0; a < 2; ++a)
#pragma unroll
            for (int b = 0; b < 2; ++b)
#pragma unroll
                for (int m = 0; m < 4; ++m)
#pragma unroll
                    for (int n = 0; n < 2; ++n) acc[a][b][m][n] = (f32x4){0.f, 0.f, 0.f, 0.f};
        cur = nxt; cA = nA; cB = nB; ++ui;
        if constexpr (ALIGN_EPI) { if (wr == 1) PG8_BAR; }
    }
    PG8_WAIT_V(0);
    if constexpr (!ALIGN_EPI) { if (wr == 0) PG8_BAR; }
    PG8_BAR;
    if constexpr (Epi::AFTER_DRAIN) { E.fused(acc, cur, wr, wc, fr, fq, lds, wid, lane); S.done(cur); }
#undef PG8_SA
#undef PG8_SB
#undef PG8_STAGE
#undef PG8_LDA
#undef PG8_LDB
#undef PG8_MMA
#undef PG8_WAIT_V
#undef PG8_WAIT_L
#undef PG8_BAR
#undef PG8_SCHED
}
}

#ifndef PG8_SP2
#define PG8_SP2 true
#endif
#ifndef PG8_ALIGN
#define PG8_ALIGN true
#endif
#ifndef MK_ONE_LAUNCH
#define MK_ONE_LAUNCH 1
#endif

constexpr int NWAVES = 8, NTHR = NWAVES * 64;
constexpr int D = 1024, DEPTH = 4, SEQ = 4096, NB_P = 4, NB_S = 128, T_S = 4;
constexpr int MP = NB_P * SEQ, MS = NB_S * T_S, M = MP + MS;
constexpr int NPROJ = 3072, NPROJ_REAL = 2824, FF = 4096, NMOD = 6 * D, CONVCH = 1536;
constexpr int PC_QA = 0, PC_KA = 512, PC_VA = 1024, PC_Z = 1536, PC_QB = 2048, PC_KB = 2560, PC_VB = 2688, PC_BLG = 2816, PC_ALG = 2820;
constexpr float EPS = 1e-6f;
constexpr size_t OY_P = 0, OY_S = OY_P + (size_t)MP * D, OCONV_P = OY_S + (size_t)MS * D, OSSM_P = OCONV_P + (size_t)DEPTH * NB_P * 3 * CONVCH,
    OK_P = OSSM_P + (size_t)DEPTH * NB_P * 4 * 128 * 128, OV_P = OK_P + (size_t)DEPTH * NB_P * 128 * 128, OCONV_S = OV_P + (size_t)DEPTH * NB_P * 128 * 128,
    OSSM_S = OCONV_S + (size_t)DEPTH * NB_S * 3 * CONVCH, OK_S = OSSM_S + (size_t)DEPTH * NB_S * 4 * 128 * 128, OV_S = OK_S + (size_t)DEPTH * NB_S * 128 * 128,
    OUT_TOTAL = OV_S + (size_t)DEPTH * NB_S * 128 * 128;
static_assert(OUT_TOTAL == 71639040, "output size");

constexpr size_t MiB = 1u << 20;
constexpr size_t WS_CTL = 0, CTL_ZERO_BYTES = 1 * MiB;
constexpr size_t WS_WIN = 1 * MiB, WS_WO = 25 * MiB, WS_WUP = 33 * MiB, WS_WDN = 65 * MiB;
constexpr size_t WS_SC = 97 * MiB;
constexpr size_t WS_MOD = 98 * MiB;
constexpr size_t WS_X = 122 * MiB;
constexpr size_t WS_XN = 188 * MiB;
constexpr size_t WS_PROJ = 221 * MiB;
constexpr size_t WS_O = 320 * MiB;
constexpr size_t WS_H = 221 * MiB;
constexpr size_t WS_MIX = 353 * MiB;
constexpr size_t WS_WADA = 419 * MiB;
constexpr size_t WS_END = 467 * MiB;
static_assert(WS_PROJ + (size_t)M * NPROJ * 2 <= WS_O && WS_O + (size_t)M * D * 2 <= WS_MIX && WS_H + (size_t)M * FF * 2 <= WS_MIX && WS_MIX + (size_t)M * D * 4 <= WS_WADA, "ws map");
static_assert(WS_X + (size_t)M * D * 4 <= WS_XN && WS_XN + (size_t)M * D * 2 <= WS_PROJ && WS_MOD + (size_t)256 * 24576 * 4 <= WS_X, "ws map 2");
constexpr int CW_BAR = 4096;

constexpr int RING_OFF = 0, RING_BYTES = 131072;
constexpr int LDS_BYTES = 155648;
constexpr int SCR_OFF = 148480;
constexpr int CTL_LDS_OFF = 153600, LDSCTL_OFF = CTL_LDS_OFF, MISC_OFF = LDSCTL_OFF + 320;

#define GAS __attribute__((address_space(1)))
#define LAS __attribute__((address_space(3)))
typedef unsigned short bf16;
typedef unsigned v4u __attribute__((ext_vector_type(4)));
typedef float f32x4 __attribute__((ext_vector_type(4)));
typedef GAS unsigned gu32;
#define LDS_WAIT() asm volatile("s_waitcnt lgkmcnt(0)" ::: "memory")
#define VM_WAIT() asm volatile("s_waitcnt vmcnt(0)" ::: "memory")
__device__ __forceinline__ unsigned f2bf(float f) { unsigned u = __builtin_bit_cast(unsigned, f); return (u + 0x7fffu + ((u >> 16) & 1u)) >> 16; }
__device__ __forceinline__ unsigned pk2(float lo, float hi) { return f2bf(lo) | (f2bf(hi) << 16); }
__device__ __forceinline__ float bf2f(bf16 h) { return __builtin_bit_cast(float, (unsigned)h << 16); }
__device__ __forceinline__ float bflo(unsigned w) { return __builtin_bit_cast(float, w << 16); }
__device__ __forceinline__ float bfhi(unsigned w) { return __builtin_bit_cast(float, w & 0xffff0000u); }
__device__ __forceinline__ float wave_sum(float v) {
#pragma unroll
    for (int o = 1; o < 64; o <<= 1) v += __shfl_xor(v, o);
    return v;
}
__device__ __forceinline__ float wave_max(float v) {
#pragma unroll
    for (int o = 1; o < 64; o <<= 1) v = fmaxf(v, __shfl_xor(v, o));
    return v;
}
__device__ __forceinline__ float siluf(float x) { return x / (1.f + __expf(-x)); }
__device__ __forceinline__ float sigmf(float x) { return 1.f / (1.f + __expf(-x)); }
__device__ __forceinline__ float softplusf(float x) { return x > 20.f ? x : log1pf(__expf(x)); }

#define RLX_AGENT __ATOMIC_RELAXED, __HIP_MEMORY_SCOPE_AGENT
#define XB_TMO      128
#define XB_XCNT(j)  (256  + 64 * (j))
#define XB_XSUB(j)  (1280 + 64 * (j))
#define XB_XGEN(j)  (2304 + 64 * (j))
#define XB_TOP      3328
#define XB_TOPGEN   3392
#define XCD_BAR_WORDS 3456
#define XB_SPIN_CAP (1u << 18)

__device__ __forceinline__ unsigned xb_ld(unsigned* p)              { return __hip_atomic_load(p, __ATOMIC_RELAXED, __HIP_MEMORY_SCOPE_AGENT); }
__device__ __forceinline__ unsigned xb_add(unsigned* p, unsigned v) { return __hip_atomic_fetch_add(p, v, __ATOMIC_RELAXED, __HIP_MEMORY_SCOPE_AGENT); }
__device__ __forceinline__ unsigned xb_xcc_id() { return (unsigned)__builtin_amdgcn_s_getreg((3 << 11) | 20) & 0xFu; }
#define XB_SPIN(cond, bar) do { unsigned _sp = 0; while (cond) { __builtin_amdgcn_s_sleep(1); \
    if ((++_sp & 255u) == 0u) { if (xb_ld(&(bar)[XB_TMO])) break; if (_sp > XB_SPIN_CAP) { atomicAdd(&(bar)[XB_TMO], 1u); break; } } } } while (0)

struct XcdBarrier {
    unsigned* bar; unsigned x;
    volatile LAS unsigned* st;
};

__device__ __forceinline__ XcdBarrier xcd_barrier_post(unsigned* bar, volatile LAS unsigned* st) {
    XcdBarrier b; b.bar = bar; b.x = xb_xcc_id(); b.st = st;
    if (threadIdx.x == 0) (void)xb_add(&bar[XB_XCNT(b.x)], 1u);
    return b;
}
__device__ __forceinline__ void xcd_barrier_complete(unsigned* bar, unsigned x, unsigned& nloc, unsigned& nx) {
    const unsigned G = gridDim.x * gridDim.y * gridDim.z;
    unsigned sum, cnt, mine, sp = 0u;
    for (;;) {
        sum = 0u; cnt = 0u; mine = 0u;
#pragma unroll
        for (unsigned j = 0; j < 16; ++j) { const unsigned c = xb_ld(&bar[XB_XCNT(j)]); sum += c; cnt += (c > 0u) ? 1u : 0u; mine = (j == x) ? c : mine; }
        if (sum == G) break;
        __builtin_amdgcn_s_sleep(1);
        if ((++sp & 255u) == 0u) { if (xb_ld(&bar[XB_TMO])) break; if (sp > XB_SPIN_CAP) { atomicAdd(&bar[XB_TMO], 1u); break; } }
    }
    nloc = mine > 0u ? mine : 1u; nx = cnt > 0u ? cnt : 1u;
}

__device__ __forceinline__ void xcd_barrier(const XcdBarrier& b) {
    asm volatile("s_waitcnt vmcnt(0)" ::: "memory");
    __syncthreads();
    if (threadIdx.x == 0) {
        unsigned* bar = b.bar;
        __builtin_amdgcn_s_waitcnt(0);
        unsigned nloc = b.st[0], nx = b.st[1];
        if (nloc == 0u) { xcd_barrier_complete(bar, b.x, nloc, nx); b.st[0] = nloc; b.st[1] = nx; }
        const unsigned old = xb_add(&bar[XB_XSUB(b.x)], 1u);
        const unsigned gen = old / nloc;
        if (old + 1u == (gen + 1u) * nloc) {
            __builtin_amdgcn_fence(__ATOMIC_RELEASE, "agent");
            asm volatile("s_waitcnt vmcnt(0)" ::: "memory");
            const unsigned og = xb_add(&bar[XB_TOP], 1u);
            const unsigned tg = og / nx;
            if (og + 1u == (tg + 1u) * nx) xb_add(&bar[XB_TOPGEN], 1u);
            else XB_SPIN(xb_ld(&bar[XB_TOPGEN]) == tg, bar);
            __builtin_amdgcn_fence(__ATOMIC_ACQUIRE, "agent");
            xb_add(&bar[XB_XGEN(b.x)], 1u);
            asm volatile("s_waitcnt vmcnt(0)" ::: "memory");
        } else {
            XB_SPIN(xb_ld(&bar[XB_XGEN(b.x)]) == gen, bar);
            __builtin_amdgcn_fence(__ATOMIC_ACQUIRE, "agent");
            asm volatile("s_waitcnt vmcnt(0)" ::: "memory");
        }
    }
    __syncthreads();
}

struct Frame {
    LAS unsigned char* lds;
    int tid, lane, wave, G, bid;
    float* out; unsigned char* ws;
};
__device__ __forceinline__ unsigned char* wsp(const Frame& F) { unsigned char* p = F.ws; asm volatile("" : "+s"(p)); return p; }
__device__ __forceinline__ LAS unsigned char* vlds(const Frame& F) { unsigned a = (unsigned)(__UINTPTR_TYPE__)F.lds; asm volatile("" : "+v"(a)); return (LAS unsigned char*)(__UINTPTR_TYPE__)a; }
constexpr int TAB_OFF = LDSCTL_OFF + 1024;
__device__ __forceinline__ const float* inp(const Frame& F, int i) {
    const unsigned long long v = ((const LAS unsigned long long*)(F.lds + TAB_OFF))[i];
    const unsigned lo = __builtin_amdgcn_readfirstlane((unsigned)v), hi = __builtin_amdgcn_readfirstlane((unsigned)(v >> 32));
    return (const float*)(((unsigned long long)hi << 32) | lo);
}
#define IN_XP 0
#define IN_XS 1
#define IN_SCONV 2
#define IN_SSSM 3
#define IN_CK 4
#define IN_CV 5
#define IN_CP 6
#define IN_CS 7
#define IN_GPREM 8
#define IN_GPOSTM 9
#define IN_GPREF 10
#define IN_GPOSTF 11
#define IN_WADA 12
#define IN_BADA 13
#define IN_WIN 14
#define IN_CONVW 15
#define IN_ALOG 16
#define IN_DTB 17
#define IN_GDNW 18
#define IN_SINKS 19
#define IN_WO 20
#define IN_WUP 21
#define IN_WDN 22

template <int MAPKIND  >
__device__ __forceinline__ void p0_transpose_item(const float* W, int K, int N, int Ndst, bf16* WT, LAS float* scr, int item, int lane) {
    const int nblk = Ndst / 32, kb = item / nblk, nb = item % nblk, k0 = 64 * kb, n0 = 32 * nb;
    const int nd = n0 + (lane & 31);
    int ns = nd;
    if (MAPKIND == 1) { ns = nd < 2048 ? nd : (nd < 2816 ? nd + 8 : (nd < 2824 ? nd - 768 : -1)); }
#pragma unroll 8
    for (int i = 0; i < 32; ++i) { const int kk = 2 * i + (lane >> 5); scr[kk * 33 + (lane & 31)] = (ns >= 0) ? W[(size_t)(k0 + kk) * N + ns] : 0.f; }
    LDS_WAIT(); asm volatile("" ::: "memory");
    const int c = lane & 7;
#pragma unroll
    for (int j = 0; j < 4; ++j) { const int n = (lane >> 3) + 8 * j; const LAS float* s = scr + (8 * c) * 33 + n;
        v4u o; o.x = pk2(s[0 * 33], s[1 * 33]); o.y = pk2(s[2 * 33], s[3 * 33]); o.z = pk2(s[4 * 33], s[5 * 33]); o.w = pk2(s[6 * 33], s[7 * 33]);
        *(GAS v4u*)(WT + (size_t)(n0 + n) * K + k0 + 8 * c) = o; }
    LDS_WAIT(); asm volatile("" ::: "memory");
}

__device__ __forceinline__ void p0_prologue(Frame& F) {
    LAS float* scr = (LAS float*)(F.lds + RING_OFF + F.wave * 16384);
    const int gw = F.bid * NWAVES + F.wave, NGW = F.G * NWAVES;
    constexpr int I_IN = (D / 64) * (NPROJ / 32), I_O = (D / 64) * (D / 32), I_UP = (D / 64) * (FF / 32), I_DN = (FF / 64) * (D / 32), I_ADA = (D / 64) * (NMOD / 32);
    constexpr int PER_L = I_IN + I_O + I_UP + I_DN + I_ADA;
    for (int it = gw; it < DEPTH * PER_L; it += NGW) {
        const int l = it / PER_L; int r = it % PER_L;
        if (r < I_IN) { p0_transpose_item<1>(inp(F, IN_WIN) + (size_t)l * D * NPROJ_REAL, D, NPROJ_REAL, NPROJ, (bf16*)(wsp(F) + WS_WIN) + (size_t)l * NPROJ * D, scr, r, F.lane); continue; } r -= I_IN;
        if (r < I_O) { p0_transpose_item<0>(inp(F, IN_WO) + (size_t)l * D * D, D, D, D, (bf16*)(wsp(F) + WS_WO) + (size_t)l * D * D, scr, r, F.lane); continue; } r -= I_O;
        if (r < I_UP) { p0_transpose_item<0>(inp(F, IN_WUP) + (size_t)l * D * FF, D, FF, FF, (bf16*)(wsp(F) + WS_WUP) + (size_t)l * FF * D, scr, r, F.lane); continue; } r -= I_UP;
        if (r < I_DN) { p0_transpose_item<0>(inp(F, IN_WDN) + (size_t)l * FF * D, FF, D, D, (bf16*)(wsp(F) + WS_WDN) + (size_t)l * D * FF, scr, r, F.lane); continue; } r -= I_DN;
        p0_transpose_item<0>(inp(F, IN_WADA) + (size_t)l * D * NMOD, D, NMOD, NMOD, (bf16*)(wsp(F) + WS_WADA) + (size_t)l * NMOD * D, scr, r, F.lane);
    }
    bf16* SC = (bf16*)(wsp(F) + WS_SC);
    for (int i = F.bid * NTHR + F.tid; i < 256 * D; i += F.G * NTHR) {
        const int r = i >> 10, c = i & 1023; float v = 0.f;
        if (r < NB_P) v = siluf(inp(F, IN_CP)[r * D + c]); else if (r < NB_P + NB_S) v = siluf(inp(F, IN_CS)[(r - NB_P) * D + c]);
        SC[i] = (bf16)f2bf(v);
    }
}

__device__ __forceinline__ const float* modp(Frame& F, int row, int l, int j) {
    const int mrow = row < MP ? (row >> 12) : NB_P + ((row - MP) >> 2);
    return (const float*)(wsp(F) + WS_MOD) + (size_t)mrow * (DEPTH * NMOD) + l * NMOD + j * D;
}
__device__ __forceinline__ void modnorm_store(Frame& F, const f32x4 (&v)[4], const float* g, const float* scale, const float* shift, bf16* orow) {
    float s = 0.f;
#pragma unroll
    for (int j = 0; j < 4; ++j) s += (v[j].x * v[j].x + v[j].y * v[j].y) + (v[j].z * v[j].z + v[j].w * v[j].w);
    const float rs = 1.0f / sqrtf(wave_sum(s) * (1.f / D) + EPS);
    GAS unsigned long long* o8 = (GAS unsigned long long*)orow + F.lane;
#pragma unroll
    for (int j = 0; j < 4; ++j) {
        const f32x4 gg = ((const f32x4*)g)[F.lane + 64 * j], sc = ((const f32x4*)scale)[F.lane + 64 * j], sh = ((const f32x4*)shift)[F.lane + 64 * j];
        const f32x4 h = (v[j] * rs) * gg * (sc + 1.0f) + sh;
        o8[64 * j] = (unsigned long long)pk2(h.x, h.y) | ((unsigned long long)pk2(h.z, h.w) << 32);
    }
}
__device__ __forceinline__ const float* xin_row(Frame& F, int row) { return row < MP ? inp(F, IN_XP) + (size_t)row * D : inp(F, IN_XS) + (size_t)(row - MP) * D; }
__device__ __forceinline__ void rowpass0(Frame& F) {
    const int gw = F.bid * NWAVES + F.wave, NGW = F.G * NWAVES;
    for (int row = gw; row < M; row += NGW) {
        const f32x4* xr = (const f32x4*)xin_row(F, row) + F.lane; f32x4 v[4];
#pragma unroll
        for (int j = 0; j < 4; ++j) v[j] = xr[64 * j];
        modnorm_store(F, v, inp(F, IN_GPREM), modp(F, row, 0, 1), modp(F, row, 0, 0), (bf16*)(wsp(F) + WS_XN) + (size_t)row * D);
    }
}
__device__ __forceinline__ void rowpass12(Frame& F, int l, int kind) {
    const int gw = F.bid * NWAVES + F.wave, NGW = F.G * NWAVES;
    float* X = (float*)(wsp(F) + WS_X); const float* MIX = (const float*)(wsp(F) + WS_MIX);
    for (int row = gw; row < M; row += NGW) {
        const float* xsrc = (l == 0 && kind == 1) ? xin_row(F, row) : X + (size_t)row * D;
        const f32x4* xr = (const f32x4*)xsrc + F.lane; const f32x4* mr = (const f32x4*)(MIX + (size_t)row * D) + F.lane;
        f32x4 x[4], m[4]; float s = 0.f;
#pragma unroll
        for (int j = 0; j < 4; ++j) { x[j] = xr[64 * j]; m[j] = mr[64 * j]; s += (m[j].x * m[j].x + m[j].y * m[j].y) + (m[j].z * m[j].z + m[j].w * m[j].w); }
        const float rs = 1.0f / sqrtf(wave_sum(s) * (1.f / D) + EPS);
        const float* gpost = inp(F, kind == 1 ? IN_GPOSTM : IN_GPOSTF) + l * D; const float* gate = modp(F, row, l, kind == 1 ? 2 : 5);
#pragma unroll
        for (int j = 0; j < 4; ++j) { const f32x4 gp = ((const f32x4*)gpost)[F.lane + 64 * j], gt = ((const f32x4*)gate)[F.lane + 64 * j]; x[j] = x[j] + gt * ((m[j] * rs) * gp); }
        const bool fin = (kind == 2 && l == DEPTH - 1);
        float* xdst = fin ? (row < MP ? F.out + OY_P + (size_t)row * D : F.out + OY_S + (size_t)(row - MP) * D) : X + (size_t)row * D;
#pragma unroll
        for (int j = 0; j < 4; ++j) ((f32x4*)xdst)[F.lane + 64 * j] = x[j];
        if (!fin) {
            if (kind == 1) modnorm_store(F, x, inp(F, IN_GPREF) + l * D, modp(F, row, l, 4), modp(F, row, l, 3), (bf16*)(wsp(F) + WS_XN) + (size_t)row * D);
            else modnorm_store(F, x, inp(F, IN_GPREM) + (l + 1) * D, modp(F, row, l + 1, 1), modp(F, row, l + 1, 0), (bf16*)(wsp(F) + WS_XN) + (size_t)row * D);
        }
    }
}

typedef short bf16x8 __attribute__((ext_vector_type(8)));
typedef float f32x16 __attribute__((ext_vector_type(16)));
typedef float f32x2_t __attribute__((ext_vector_type(2))); typedef __bf16 bf16x2_t __attribute__((ext_vector_type(2)));
typedef unsigned v2u __attribute__((ext_vector_type(2)));
#define MFMA32(a, b, c) __builtin_amdgcn_mfma_f32_32x32x16_bf16((a), (b), (c), 0, 0, 0)
__device__ __forceinline__ unsigned cvtpk(float lo, float hi) { f32x2_t v = {lo, hi}; bf16x2_t b = __builtin_convertvector(v, bf16x2_t); return __builtin_bit_cast(unsigned, b); }
__device__ __forceinline__ int crow(int i, int h) { return (i & 3) + 8 * (i >> 2) + 4 * h; }
__device__ __forceinline__ bf16x8 pack8(const f32x16& x, int s, float sc) {
    v4u p; p.x = cvtpk(x[8 * s] * sc, x[8 * s + 1] * sc); p.y = cvtpk(x[8 * s + 2] * sc, x[8 * s + 3] * sc); p.z = cvtpk(x[8 * s + 4] * sc, x[8 * s + 5] * sc); p.w = cvtpk(x[8 * s + 6] * sc, x[8 * s + 7] * sc);
    return __builtin_bit_cast(bf16x8, p);
}
constexpr size_t WS_GDN = 353 * MiB;
constexpr int GDN_CH_BYTES = 73728, GDN_STAGE_BYTES = 57344;
constexpr int GO_NW = 0, GO_QG = 16384, GO_KGT = 32768, GO_ATT = 49152, GO_U = 57344;
constexpr size_t WS_GL = WS_GDN + (size_t)1024 * GDN_CH_BYTES;
static_assert(WS_GL + 4096 <= WS_END, "gdn region");
constexpr int PL_KN = 0, PL_QN = 17408, PL_KBGT = 34816, PL_VBT = 53248, PL_KGT = 71680, PL_QG = 89088, PL_L = 105984, PL_T = 122368, PL_VEC = SCR_OFF;
static_assert(PL_T + 64 * 144 <= SCR_OFF, "prep lds");

__device__ __forceinline__ void gdn_prep_unit(Frame& F, int l, int unit) {
    const int b = unit >> 8, h = (unit >> 6) & 3, c = unit & 63, t0 = c * 64, R0 = b * SEQ + t0;
    int tid_ = F.tid; asm volatile("" : "+v"(tid_));
    const int tid = tid_, lane = tid & 63, wave = F.wave, r = lane & 31, hh = lane >> 5;
    const bf16* PROJ = (const bf16*)(wsp(F) + WS_PROJ);
    unsigned char* gout = wsp(F) + WS_GDN + (size_t)unit * GDN_CH_BYTES;
    LAS unsigned char* lds = vlds(F);
    LAS float* VEC = (LAS float*)(lds + PL_VEC);
    __syncthreads();
    if (wave == 0) {
        const bf16* prow = PROJ + (size_t)(R0 + lane) * NPROJ;
        const float bl = bf2f(prow[PC_BLG + h]), al = bf2f(prow[PC_ALG + h]);
        float g = -__expf(inp(F, IN_ALOG)[l * 4 + h]) * softplusf(al + inp(F, IN_DTB)[l * 4 + h]);
#pragma unroll
        for (int o = 1; o < 64; o <<= 1) { const float v = __shfl_up(g, o); if (lane >= o) g += v; }
        const float glast = __shfl(g, 63);
        VEC[lane] = g; VEC[64 + lane] = sigmf(bl); VEC[128 + lane] = __expf(g); VEC[192 + lane] = __expf(glast - g);
        if (lane == 0) ((float*)(wsp(F) + WS_GL))[unit] = __expf(glast);
    }
    __syncthreads();
    {
        const int t = tid >> 3, d0 = (tid & 7) * 16;
        const float beta = VEC[64 + t], eg = VEC[128 + t], ek = VEC[192 + t];
        const float* cwb = inp(F, IN_CONVW) + (size_t)l * 4 * CONVCH;
#pragma unroll 1
        for (int m = 0; m < 3; ++m) {
            const int col = m * 512 + h * 128 + d0;
            float acc[16], xl[16];
#pragma unroll
            for (int e = 0; e < 16; ++e) { acc[e] = 0.f; xl[e] = 0.f; }
#pragma unroll
            for (int i = 0; i < 4; ++i) {
                const int tt = t0 + t - 3 + i;
                v4u w0 = (v4u){0u, 0u, 0u, 0u}, w1 = w0;
                if (tt >= 0) { const v4u* p = (const v4u*)(PROJ + (size_t)(b * SEQ + tt) * NPROJ + col); w0 = p[0]; w1 = p[1]; }
                const f32x4* cp = (const f32x4*)(cwb + i * CONVCH + col);
                const f32x4 c0 = cp[0], c1 = cp[1], c2 = cp[2], c3 = cp[3];
                float x[16];
                x[0] = bflo(w0.x); x[1] = bfhi(w0.x); x[2] = bflo(w0.y); x[3] = bfhi(w0.y); x[4] = bflo(w0.z); x[5] = bfhi(w0.z); x[6] = bflo(w0.w); x[7] = bfhi(w0.w);
                x[8] = bflo(w1.x); x[9] = bfhi(w1.x); x[10] = bflo(w1.y); x[11] = bfhi(w1.y); x[12] = bflo(w1.z); x[13] = bfhi(w1.z); x[14] = bflo(w1.w); x[15] = bfhi(w1.w);
                acc[0] += c0.x * x[0]; acc[1] += c0.y * x[1]; acc[2] += c0.z * x[2]; acc[3] += c0.w * x[3];
                acc[4] += c1.x * x[4]; acc[5] += c1.y * x[5]; acc[6] += c1.z * x[6]; acc[7] += c1.w * x[7];
                acc[8] += c2.x * x[8]; acc[9] += c2.y * x[9]; acc[10] += c2.z * x[10]; acc[11] += c2.w * x[11];
                acc[12] += c3.x * x[12]; acc[13] += c3.y * x[13]; acc[14] += c3.z * x[14]; acc[15] += c3.w * x[15];
                if (i == 3) {
#pragma unroll
                    for (int e = 0; e < 16; ++e) xl[e] = x[e];
                }
            }
            if (c == 63 && t >= 61) {
                float* co = F.out + OCONV_P + ((size_t)(l * NB_P + b) * 3 + (t - 61)) * CONVCH + col;
#pragma unroll
                for (int e = 0; e < 16; ++e) co[e] = xl[e];
            }
            float ss = 0.f;
#pragma unroll
            for (int e = 0; e < 16; ++e) { acc[e] = siluf(acc[e]); ss += acc[e] * acc[e]; }
            ss += __shfl_xor(ss, 1); ss += __shfl_xor(ss, 2); ss += __shfl_xor(ss, 4);
            const float rs = 1.0f / sqrtf(ss + EPS);
            if (m == 0) {
                const float sq = rs * 0.08838834764831845f, sg = sq * eg;
                v4u a0, a1, g0, g1;
                a0.x = cvtpk(acc[0] * sq, acc[1] * sq); a0.y = cvtpk(acc[2] * sq, acc[3] * sq); a0.z = cvtpk(acc[4] * sq, acc[5] * sq); a0.w = cvtpk(acc[6] * sq, acc[7] * sq);
                a1.x = cvtpk(acc[8] * sq, acc[9] * sq); a1.y = cvtpk(acc[10] * sq, acc[11] * sq); a1.z = cvtpk(acc[12] * sq, acc[13] * sq); a1.w = cvtpk(acc[14] * sq, acc[15] * sq);
                g0.x = cvtpk(acc[0] * sg, acc[1] * sg); g0.y = cvtpk(acc[2] * sg, acc[3] * sg); g0.z = cvtpk(acc[4] * sg, acc[5] * sg); g0.w = cvtpk(acc[6] * sg, acc[7] * sg);
                g1.x = cvtpk(acc[8] * sg, acc[9] * sg); g1.y = cvtpk(acc[10] * sg, acc[11] * sg); g1.z = cvtpk(acc[12] * sg, acc[13] * sg); g1.w = cvtpk(acc[14] * sg, acc[15] * sg);
                *(LAS v4u*)(lds + PL_QN + t * 272 + d0 * 2) = a0; *(LAS v4u*)(lds + PL_QN + t * 272 + d0 * 2 + 16) = a1;
                *(LAS v2u*)(lds + PL_QG + t * 264 + d0 * 2) = (v2u){g0.x, g0.y}; *(LAS v2u*)(lds + PL_QG + t * 264 + d0 * 2 + 8) = (v2u){g0.z, g0.w};
                *(LAS v2u*)(lds + PL_QG + t * 264 + d0 * 2 + 16) = (v2u){g1.x, g1.y}; *(LAS v2u*)(lds + PL_QG + t * 264 + d0 * 2 + 24) = (v2u){g1.z, g1.w};
            } else if (m == 1) {
                v4u a0, a1;
                a0.x = cvtpk(acc[0] * rs, acc[1] * rs); a0.y = cvtpk(acc[2] * rs, acc[3] * rs); a0.z = cvtpk(acc[4] * rs, acc[5] * rs); a0.w = cvtpk(acc[6] * rs, acc[7] * rs);
                a1.x = cvtpk(acc[8] * rs, acc[9] * rs); a1.y = cvtpk(acc[10] * rs, acc[11] * rs); a1.z = cvtpk(acc[12] * rs, acc[13] * rs); a1.w = cvtpk(acc[14] * rs, acc[15] * rs);
                *(LAS v4u*)(lds + PL_KN + t * 272 + d0 * 2) = a0; *(LAS v4u*)(lds + PL_KN + t * 272 + d0 * 2 + 16) = a1;
                const float sb = rs * beta * eg, sk = rs * ek;
#pragma unroll
                for (int e = 0; e < 16; ++e) {
                    *(LAS bf16*)(lds + PL_KBGT + (d0 + e) * 144 + t * 2) = (bf16)f2bf(acc[e] * sb);
                    *(LAS bf16*)(lds + PL_KGT + (d0 + e) * 136 + t * 2) = (bf16)f2bf(acc[e] * sk);
                }
            } else {
#pragma unroll
                for (int e = 0; e < 16; ++e) *(LAS bf16*)(lds + PL_VBT + (d0 + e) * 144 + t * 2) = (bf16)f2bf(acc[e] * beta);
            }
        }
    }
    __syncthreads();
    if (wave < 6) {
        const bool isqk = wave >= 3; const int tsel = isqk ? wave - 3 : wave;
        const int ta = isqk ? (tsel == 2 ? 1 : 0) : (tsel == 0 ? 0 : 1);
        const int tb = isqk ? (tsel == 0 ? 0 : 1) : (tsel == 2 ? 1 : 0);
        const int boff = isqk ? PL_QN : PL_KN;
        f32x16 acc;
#pragma unroll
        for (int i = 0; i < 16; ++i) acc[i] = 0.f;
#pragma unroll
        for (int s = 0; s < 8; ++s) {
            const bf16x8 a = *(const LAS bf16x8*)(lds + PL_KN + (32 * ta + r) * 272 + (16 * s + 8 * hh) * 2);
            const bf16x8 bb = *(const LAS bf16x8*)(lds + boff + (32 * tb + r) * 272 + (16 * s + 8 * hh) * 2);
            acc = MFMA32(a, bb, acc);
        }
        if (!isqk) {
            const int j = 32 * tb + r; const float gj = VEC[j];
#pragma unroll
            for (int i2 = 0; i2 < 16; ++i2) { const int i = 32 * ta + crow(i2, hh);
                const float v = (i > j) ? VEC[64 + i] * acc[i2] * __expf(fminf(VEC[i] - gj, 0.f)) : 0.f;
                ((LAS float*)(lds + PL_L))[i * 64 + j] = v; }
        } else {
            const int cq = 32 * tb + r; const float gq = VEC[cq];
#pragma unroll
            for (int i2 = 0; i2 < 16; ++i2) { const int cp = 32 * ta + crow(i2, hh);
                acc[i2] = (cq >= cp) ? acc[i2] * __expf(fminf(gq - VEC[cp], 0.f)) : 0.f; }
#pragma unroll
            for (int s = 0; s < 2; ++s) *(v4u*)(gout + GO_ATT + ((tb * 4 + 2 * ta + s) * 64 + lane) * 16) = __builtin_bit_cast(v4u, pack8(acc, s, 1.f));
        }
    } else if (wave == 6) {
#pragma unroll
        for (int s = 0; s < 2; ++s) *(v4u*)(gout + GO_ATT + ((0 * 4 + 2 * 1 + s) * 64 + lane) * 16) = (v4u){0u, 0u, 0u, 0u};
    }
    __syncthreads();
    if (wave == 0) {
        float tc[64];
        const LAS float* Lm = (const LAS float*)(lds + PL_L);
#pragma unroll
        for (int i = 0; i < 64; ++i) {
            float a = (i == lane) ? 1.f : 0.f;
#pragma unroll
            for (int m = 0; m < i; ++m) a -= Lm[i * 64 + m] * tc[m];
            tc[i] = a;
        }
#pragma unroll
        for (int i = 0; i < 64; ++i) *(LAS bf16*)(lds + PL_T + i * 144 + lane * 2) = (bf16)f2bf(tc[i]);
    } else {
        for (int f = wave - 1; f < 32; f += 7) {
            if (f < 16) {
                const int ct = f >> 3, kk = f & 7, k0 = 32 * (kk >> 1) + 16 * (kk & 1) + 4 * hh;
                const v2u lo = *(const LAS v2u*)(lds + PL_QG + (32 * ct + r) * 264 + k0 * 2), hi = *(const LAS v2u*)(lds + PL_QG + (32 * ct + r) * 264 + (k0 + 8) * 2);
                *(v4u*)(gout + GO_QG + (f * 64 + lane) * 16) = (v4u){lo.x, lo.y, hi.x, hi.y};
            } else {
                const int g = f - 16, rt = g >> 2, k2 = g & 3, c0 = 32 * (k2 >> 1) + 16 * (k2 & 1) + 4 * hh;
                const v2u lo = *(const LAS v2u*)(lds + PL_KGT + (32 * rt + r) * 136 + c0 * 2), hi = *(const LAS v2u*)(lds + PL_KGT + (32 * rt + r) * 136 + (c0 + 8) * 2);
                *(v4u*)(gout + GO_KGT + (g * 64 + lane) * 16) = (v4u){lo.x, lo.y, hi.x, hi.y};
            }
        }
    }
    __syncthreads();
    {
        const int rt = wave >> 1, ct = wave & 1;
        f32x16 acc;
#pragma unroll
        for (int i = 0; i < 16; ++i) acc[i] = 0.f;
#pragma unroll
        for (int s = 0; s < 4; ++s) {
            const bf16x8 a = *(const LAS bf16x8*)(lds + PL_KBGT + (32 * rt + r) * 144 + (16 * s + 8 * hh) * 2);
            const bf16x8 bb = *(const LAS bf16x8*)(lds + PL_T + (32 * ct + r) * 144 + (16 * s + 8 * hh) * 2);
            acc = MFMA32(a, bb, acc);
        }
#pragma unroll
        for (int s = 0; s < 2; ++s) *(v4u*)(gout + GO_NW + ((ct * 8 + 2 * rt + s) * 64 + lane) * 16) = __builtin_bit_cast(v4u, pack8(acc, s, -1.f));
    }
    {
        const int ct = wave >> 2, wv = wave & 3;
        f32x16 acc;
#pragma unroll
        for (int i = 0; i < 16; ++i) acc[i] = 0.f;
#pragma unroll
        for (int s = 0; s < 4; ++s) {
            const bf16x8 a = *(const LAS bf16x8*)(lds + PL_T + (32 * ct + r) * 144 + (16 * s + 8 * hh) * 2);
            const bf16x8 bb = *(const LAS bf16x8*)(lds + PL_VBT + (32 * wv + r) * 144 + (16 * s + 8 * hh) * 2);
            acc = MFMA32(a, bb, acc);
        }
        v4u* up = (v4u*)(gout + GO_U + ((wv * 2 + ct) * 64 + lane) * 32);
        up[0] = __builtin_bit_cast(v4u, pack8(acc, 0, 1.f)); up[1] = __builtin_bit_cast(v4u, pack8(acc, 1, 1.f));
    }
}

constexpr int SL_STAGE1 = 57344, SL_O0 = 114688, SL_O1 = 131584, SL_OSTRIDE = 264;
static_assert(SL_O1 + 64 * SL_OSTRIDE <= CTL_LDS_OFF, "scan lds");

__device__ __forceinline__ void gdn_scan(Frame& F, int l, int bh) {
    const int b = bh >> 2, h = bh & 3;
    const int tid = F.tid, lane = F.lane, wave = F.wave, r = lane & 31, hh = lane >> 5;
    LAS unsigned char* lds = vlds(F);
    const unsigned char* gin = wsp(F) + WS_GDN + (size_t)(bh * 64) * GDN_CH_BYTES;
    __syncthreads();
    if (wave < 4) {
        const float* GLp = (const float*)(wsp(F) + WS_GL) + bh * 64;
        f32x16 S0, S1, S2, S3;
#pragma unroll
        for (int i = 0; i < 16; ++i) { S0[i] = 0.f; S1[i] = 0.f; S2[i] = 0.f; S3[i] = 0.f; }
        v4u u0a, u0b, u1a, u1b;
        { const v4u* up = (const v4u*)(gin + GO_U + ((wave * 2 + 0) * 64 + lane) * 32); u0a = up[0]; u0b = up[1]; const v4u* uq = (const v4u*)(gin + GO_U + ((wave * 2 + 1) * 64 + lane) * 32); u1a = uq[0]; u1b = uq[1]; }
        float gl = GLp[0];
        __syncthreads();
#pragma unroll 1
        for (int c = 0; c < 64; ++c) {
            LAS unsigned char* st = lds + (c & 1) * SL_STAGE1;
            f32x16 vn0, vn1, o0, o1;
            vn0[0] = bflo(u0a.x); vn0[1] = bfhi(u0a.x); vn0[2] = bflo(u0a.y); vn0[3] = bfhi(u0a.y); vn0[4] = bflo(u0a.z); vn0[5] = bfhi(u0a.z); vn0[6] = bflo(u0a.w); vn0[7] = bfhi(u0a.w);
            vn0[8] = bflo(u0b.x); vn0[9] = bfhi(u0b.x); vn0[10] = bflo(u0b.y); vn0[11] = bfhi(u0b.y); vn0[12] = bflo(u0b.z); vn0[13] = bfhi(u0b.z); vn0[14] = bflo(u0b.w); vn0[15] = bfhi(u0b.w);
            vn1[0] = bflo(u1a.x); vn1[1] = bfhi(u1a.x); vn1[2] = bflo(u1a.y); vn1[3] = bfhi(u1a.y); vn1[4] = bflo(u1a.z); vn1[5] = bfhi(u1a.z); vn1[6] = bflo(u1a.w); vn1[7] = bfhi(u1a.w);
            vn1[8] = bflo(u1b.x); vn1[9] = bfhi(u1b.x); vn1[10] = bflo(u1b.y); vn1[11] = bfhi(u1b.y); vn1[12] = bflo(u1b.z); vn1[13] = bfhi(u1b.z); vn1[14] = bflo(u1b.w); vn1[15] = bfhi(u1b.w);
#pragma unroll
            for (int i = 0; i < 16; ++i) { o0[i] = 0.f; o1[i] = 0.f; }
            const float glc = gl;
            if (c + 1 < 64) { const unsigned char* gn = gin + (size_t)(c + 1) * GDN_CH_BYTES;
                const v4u* up = (const v4u*)(gn + GO_U + ((wave * 2 + 0) * 64 + lane) * 32); u0a = up[0]; u0b = up[1];
                const v4u* uq = (const v4u*)(gn + GO_U + ((wave * 2 + 1) * 64 + lane) * 32); u1a = uq[0]; u1b = uq[1]; gl = GLp[c + 1]; }
#pragma unroll
            for (int kk = 0; kk < 8; ++kk) {
                const bf16x8 sb = pack8(kk < 2 ? S0 : (kk < 4 ? S1 : (kk < 6 ? S2 : S3)), kk & 1, 1.f);
                const bf16x8 a0 = *(const LAS bf16x8*)(st + GO_NW + ((0 * 8 + kk) * 64 + lane) * 16), a1 = *(const LAS bf16x8*)(st + GO_NW + ((1 * 8 + kk) * 64 + lane) * 16);
                const bf16x8 q0 = *(const LAS bf16x8*)(st + GO_QG + ((0 * 8 + kk) * 64 + lane) * 16), q1 = *(const LAS bf16x8*)(st + GO_QG + ((1 * 8 + kk) * 64 + lane) * 16);
                vn0 = MFMA32(a0, sb, vn0); vn1 = MFMA32(a1, sb, vn1);
                o0 = MFMA32(q0, sb, o0); o1 = MFMA32(q1, sb, o1);
            }
            bf16x8 vb[4];
            vb[0] = pack8(vn0, 0, 1.f); vb[1] = pack8(vn0, 1, 1.f); vb[2] = pack8(vn1, 0, 1.f); vb[3] = pack8(vn1, 1, 1.f);
#pragma unroll
            for (int i = 0; i < 16; ++i) { S0[i] *= glc; S1[i] *= glc; S2[i] *= glc; S3[i] *= glc; }
#pragma unroll
            for (int k2 = 0; k2 < 4; ++k2) {
                const bf16x8 t0 = *(const LAS bf16x8*)(st + GO_ATT + ((0 * 4 + k2) * 64 + lane) * 16), t1 = *(const LAS bf16x8*)(st + GO_ATT + ((1 * 4 + k2) * 64 + lane) * 16);
                o0 = MFMA32(t0, vb[k2], o0); o1 = MFMA32(t1, vb[k2], o1);
                const bf16x8 g0 = *(const LAS bf16x8*)(st + GO_KGT + ((0 * 4 + k2) * 64 + lane) * 16), g1 = *(const LAS bf16x8*)(st + GO_KGT + ((1 * 4 + k2) * 64 + lane) * 16);
                const bf16x8 g2 = *(const LAS bf16x8*)(st + GO_KGT + ((2 * 4 + k2) * 64 + lane) * 16), g3 = *(const LAS bf16x8*)(st + GO_KGT + ((3 * 4 + k2) * 64 + lane) * 16);
                S0 = MFMA32(g0, vb[k2], S0); S1 = MFMA32(g1, vb[k2], S1); S2 = MFMA32(g2, vb[k2], S2); S3 = MFMA32(g3, vb[k2], S3);
            }
            LAS unsigned char* ot = lds + ((c & 1) ? SL_O1 : SL_O0) + (32 * wave + r) * 2;
#pragma unroll
            for (int i = 0; i < 16; ++i) { *(LAS bf16*)(ot + crow(i, hh) * SL_OSTRIDE) = (bf16)f2bf(o0[i]); *(LAS bf16*)(ot + (32 + crow(i, hh)) * SL_OSTRIDE) = (bf16)f2bf(o1[i]); }
            __syncthreads();
        }
        __syncthreads();
        float* so = F.out + OSSM_P + ((size_t)(l * NB_P + b) * 4 + h) * 16384 + 32 * wave + r;
#pragma unroll
        for (int i = 0; i < 16; ++i) { so[(0 + crow(i, hh)) * 128] = S0[i]; so[(32 + crow(i, hh)) * 128] = S1[i]; so[(64 + crow(i, hh)) * 128] = S2[i]; so[(96 + crow(i, hh)) * 128] = S3[i]; }
    } else {
        const int lt = tid - 256;
        const bf16* PROJ = (const bf16*)(wsp(F) + WS_PROJ); bf16* O = (bf16*)(wsp(F) + WS_O);
        const int orow = lt >> 2, oq = lt & 3;
        float gw[32];
        { const float* gp = inp(F, IN_GDNW) + l * 128 + oq * 32;
#pragma unroll
          for (int e = 0; e < 32; ++e) gw[e] = gp[e]; }
        { const v4u* src = (const v4u*)gin + lt; v4u tmp[14];
#pragma unroll
          for (int j = 0; j < 14; ++j) tmp[j] = src[j * 256];
#pragma unroll
          for (int j = 0; j < 14; ++j) *(LAS v4u*)(lds + (j * 256 + lt) * 16) = tmp[j]; }
        __syncthreads();
#pragma unroll 1
        for (int c = 0; c <= 64; ++c) {
            if (c + 1 < 64) {
                const v4u* src = (const v4u*)(gin + (size_t)(c + 1) * GDN_CH_BYTES) + lt; LAS unsigned char* dst = lds + ((c + 1) & 1) * SL_STAGE1; v4u tmp[14];
#pragma unroll
                for (int j = 0; j < 14; ++j) tmp[j] = src[j * 256];
#pragma unroll
                for (int j = 0; j < 14; ++j) *(LAS v4u*)(dst + (j * 256 + lt) * 16) = tmp[j];
            }
            if (c >= 1) {
                const int cc = c - 1; const LAS unsigned char* ot = lds + ((cc & 1) ? SL_O1 : SL_O0) + orow * SL_OSTRIDE + oq * 64;
                const size_t row = (size_t)(b * SEQ + cc * 64 + orow);
                float ov[32]; float ss = 0.f;
#pragma unroll
                for (int j = 0; j < 8; ++j) { const v2u w = *(const LAS v2u*)(ot + j * 8); ov[4 * j] = bflo(w.x); ov[4 * j + 1] = bfhi(w.x); ov[4 * j + 2] = bflo(w.y); ov[4 * j + 3] = bfhi(w.y); }
#pragma unroll
                for (int e = 0; e < 32; ++e) ss += ov[e] * ov[e];
                ss += __shfl_xor(ss, 1); ss += __shfl_xor(ss, 2);
                const float rn = 1.0f / sqrtf(ss * (1.f / 128.f) + EPS);
                const v4u* zp = (const v4u*)(PROJ + row * NPROJ + PC_Z + h * 128 + oq * 32);
                v4u* op = (v4u*)(O + row * D + h * 128 + oq * 32);
#pragma unroll
                for (int j = 0; j < 4; ++j) { const v4u zw = zp[j]; float z[8];
                    z[0] = bflo(zw.x); z[1] = bfhi(zw.x); z[2] = bflo(zw.y); z[3] = bfhi(zw.y); z[4] = bflo(zw.z); z[5] = bfhi(zw.z); z[6] = bflo(zw.w); z[7] = bfhi(zw.w);
                    float y[8];
#pragma unroll
                    for (int e = 0; e < 8; ++e) y[e] = ov[8 * j + e] * rn * gw[8 * j + e] * siluf(z[e]);
                    v4u ow; ow.x = cvtpk(y[0], y[1]); ow.y = cvtpk(y[2], y[3]); ow.z = cvtpk(y[4], y[5]); ow.w = cvtpk(y[6], y[7]);
                    op[j] = ow; }
            }
            if (c < 64) __syncthreads();
        }
        __syncthreads();
    }
}

constexpr int WL_K = 0, WL_KSTR = 144, WL_VT = 36864, WL_VSTR = 520;
static_assert(WL_VT + 64 * WL_VSTR <= SCR_OFF, "swa lds");
__device__ __forceinline__ void swa_unit(Frame& F, int l, int unit) {
    const int b = unit >> 6, qb = (unit >> 1) & 31, kvh = unit & 1;
    int tid_ = F.tid; asm volatile("" : "+v"(tid_));
    const int tid = tid_, lane = tid & 63, wave = F.wave, r = lane & 31, hh = lane >> 5;
    const bf16* PROJ = (const bf16*)(wsp(F) + WS_PROJ); bf16* O = (bf16*)(wsp(F) + WS_O);
    LAS unsigned char* lds = vlds(F);
    __syncthreads();
#pragma unroll
    for (int j = 0; j < 4; ++j) {
        const int idx = tid + 512 * j, row = idx >> 3, seg = idx & 7;
        const int s = (qb - 1) * 128 + row;
        v4u kw = (v4u){0u, 0u, 0u, 0u}, vw = kw;
        if (s >= 0) { const bf16* p = PROJ + (size_t)(b * SEQ + s) * NPROJ + kvh * 64 + seg * 8; kw = *(const v4u*)(p + PC_KB); vw = *(const v4u*)(p + PC_VB); }
        *(LAS v4u*)(lds + WL_K + row * WL_KSTR + seg * 16) = kw;
        LAS unsigned char* vt = lds + WL_VT + (seg * 8) * WL_VSTR + row * 2;
        *(LAS bf16*)(vt + 0 * WL_VSTR) = (bf16)(vw.x & 0xffffu); *(LAS bf16*)(vt + 1 * WL_VSTR) = (bf16)(vw.x >> 16);
        *(LAS bf16*)(vt + 2 * WL_VSTR) = (bf16)(vw.y & 0xffffu); *(LAS bf16*)(vt + 3 * WL_VSTR) = (bf16)(vw.y >> 16);
        *(LAS bf16*)(vt + 4 * WL_VSTR) = (bf16)(vw.z & 0xffffu); *(LAS bf16*)(vt + 5 * WL_VSTR) = (bf16)(vw.z >> 16);
        *(LAS bf16*)(vt + 6 * WL_VSTR) = (bf16)(vw.w & 0xffffu); *(LAS bf16*)(vt + 7 * WL_VSTR) = (bf16)(vw.w >> 16);
        if (qb == 31 && row >= 128) {
            float* ko = F.out + OK_P + ((size_t)(l * NB_P + b) * 128 + (row - 128)) * 128 + kvh * 64 + seg * 8; float* vo = F.out + OV_P + ((size_t)(l * NB_P + b) * 128 + (row - 128)) * 128 + kvh * 64 + seg * 8;
            *(f32x4*)ko = (f32x4){bflo(kw.x), bfhi(kw.x), bflo(kw.y), bfhi(kw.y)}; *(f32x4*)(ko + 4) = (f32x4){bflo(kw.z), bfhi(kw.z), bflo(kw.w), bfhi(kw.w)};
            *(f32x4*)vo = (f32x4){bflo(vw.x), bfhi(vw.x), bflo(vw.y), bfhi(vw.y)}; *(f32x4*)(vo + 4) = (f32x4){bflo(vw.z), bfhi(vw.z), bflo(vw.w), bfhi(vw.w)};
        }
    }
    __syncthreads();
    const int g = wave >> 1, qh = wave & 1;
    const float sink = inp(F, IN_SINKS)[l * 8 + kvh * 4 + g];
#pragma unroll 1
    for (int qa = 0; qa < 2; ++qa) {
        const int a = 2 * qh + qa;
        const int iq = 32 * a + r;
        const size_t qrow = (size_t)(b * SEQ + qb * 128 + iq);
        bf16x8 qf[4];
#pragma unroll
        for (int ks = 0; ks < 4; ++ks) qf[ks] = *(const bf16x8*)(PROJ + qrow * NPROJ + PC_QB + (kvh * 4 + g) * 64 + 16 * ks + 8 * hh);
        f32x16 P[5];
#pragma unroll
        for (int kt = 0; kt < 5; ++kt) {
#pragma unroll
            for (int i = 0; i < 16; ++i) P[kt][i] = 0.f;
#pragma unroll
            for (int ks = 0; ks < 4; ++ks) {
                const bf16x8 kf = *(const LAS bf16x8*)(lds + WL_K + (32 * (a + kt) + r) * WL_KSTR + (16 * ks + 8 * hh) * 2);
                P[kt] = MFMA32(kf, qf[ks], P[kt]);
            }
        }
        float mx = -INFINITY;
#pragma unroll
        for (int kt = 0; kt < 5; ++kt)
#pragma unroll
            for (int i = 0; i < 16; ++i) {
                const int kj = 32 * (a + kt) + crow(i, hh);
                const bool ok = (kj > iq) && (kj <= iq + 128) && (qb > 0 || kj >= 128);
                const float s = ok ? P[kt][i] * 0.125f : -INFINITY;
                P[kt][i] = s; mx = fmaxf(mx, s);
            }
        mx = fmaxf(mx, __shfl_xor(mx, 32)); mx = fmaxf(mx, sink);
        float sum = 0.f;
#pragma unroll
        for (int kt = 0; kt < 5; ++kt)
#pragma unroll
            for (int i = 0; i < 16; ++i) { const float p = __expf(P[kt][i] - mx); P[kt][i] = p; sum += p; }
        sum += __shfl_xor(sum, 32);
        const float inv = 1.0f / (sum + __expf(sink - mx));
        f32x16 o0, o1;
#pragma unroll
        for (int i = 0; i < 16; ++i) { o0[i] = 0.f; o1[i] = 0.f; }
#pragma unroll
        for (int kt = 0; kt < 5; ++kt)
#pragma unroll
            for (int s = 0; s < 2; ++s) {
                const bf16x8 pb = pack8(P[kt], s, inv);
                const int key0 = 32 * (a + kt) + 16 * s + 4 * hh;
                const LAS unsigned char* v0 = lds + WL_VT + r * WL_VSTR + key0 * 2; const LAS unsigned char* v1 = v0 + 32 * WL_VSTR;
                const v2u a0l = *(const LAS v2u*)v0, a0h = *(const LAS v2u*)(v0 + 16), a1l = *(const LAS v2u*)v1, a1h = *(const LAS v2u*)(v1 + 16);
                o0 = MFMA32(__builtin_bit_cast(bf16x8, ((v4u){a0l.x, a0l.y, a0h.x, a0h.y})), pb, o0);
                o1 = MFMA32(__builtin_bit_cast(bf16x8, ((v4u){a1l.x, a1l.y, a1h.x, a1h.y})), pb, o1);
            }
        bf16* orow = O + qrow * D + 512 + (kvh * 4 + g) * 64 + 4 * hh;
#pragma unroll
        for (int k = 0; k < 4; ++k) {
            *(v2u*)(orow + 8 * k) = (v2u){cvtpk(o0[4 * k], o0[4 * k + 1]), cvtpk(o0[4 * k + 2], o0[4 * k + 3])};
            *(v2u*)(orow + 32 + 8 * k) = (v2u){cvtpk(o1[4 * k], o1[4 * k + 1]), cvtpk(o1[4 * k + 2], o1[4 * k + 3])};
        }
    }
}

__device__ __forceinline__ void gdn_naive_item(Frame& F, int l, int row0, int T, int h, const float* S0, const float* cbuf, float* Sout, float* convout) {
    LAS float* sm = (LAS float*)(F.lds + RING_OFF);
    LAS float* red = sm + 384; LAS float* red2 = sm + 896; LAS float* part = sm + 1408; LAS float* part2 = sm + 1416; LAS float* scal = sm + 1424;
    const int tid = F.tid, v = tid & 127, kq = tid >> 7;
    const bf16* PROJ = (const bf16*)(wsp(F) + WS_PROJ); bf16* O = (bf16*)(wsp(F) + WS_O);
    float S[32];
#pragma unroll
    for (int i = 0; i < 32; ++i) S[i] = S0 ? S0[(kq * 32 + i) * 128 + v] : 0.f;
    float x1 = 0.f, x2 = 0.f, x3 = 0.f, cw0 = 0.f, cw1 = 0.f, cw2 = 0.f, cw3 = 0.f; int ch = 0;
    if (tid < 384) {
        ch = (tid >> 7) * 512 + h * 128 + (tid & 127);
        const float* cw = inp(F, IN_CONVW) + (size_t)l * 4 * CONVCH;
        cw0 = cw[ch]; cw1 = cw[CONVCH + ch]; cw2 = cw[2 * CONVCH + ch]; cw3 = cw[3 * CONVCH + ch];
        if (cbuf) { x1 = cbuf[ch]; x2 = cbuf[CONVCH + ch]; x3 = cbuf[2 * CONVCH + ch]; }
    }
    const float Aexp = __expf(inp(F, IN_ALOG)[l * 4 + h]), dtb = inp(F, IN_DTB)[l * 4 + h];
    const float gw = inp(F, IN_GDNW)[l * 128 + v];
    __syncthreads();
    for (int t = 0; t < T; ++t) {
        const size_t row = (size_t)(row0 + t); const bf16* prow = PROJ + row * NPROJ;
        if (tid < 384) {
            const float x = bf2f(prow[ch]);
            const float a = cw0 * x1 + cw1 * x2 + cw2 * x3 + cw3 * x; x1 = x2; x2 = x3; x3 = x;
            const float xc = siluf(a); sm[tid] = xc;
            const float ss = wave_sum(xc * xc); if (F.lane == 0) part[F.wave] = ss;
        }
        if (tid == 384) {
            const float bl = bf2f(prow[PC_BLG + h]), al = bf2f(prow[PC_ALG + h]);
            scal[0] = sigmf(bl); scal[1] = __expf(-Aexp * softplusf(al + dtb));
        }
        __syncthreads();
        const float rq = (1.0f / sqrtf(part[0] + part[1] + EPS)) * 0.08838834764831845f, rk = 1.0f / sqrtf(part[2] + part[3] + EPS);
        const float beta = scal[0], a = scal[1];
        float p = 0.f;
#pragma unroll
        for (int i = 0; i < 32; ++i) { S[i] *= a; p += S[i] * (sm[128 + kq * 32 + i] * rk); }
        red[kq * 128 + v] = p;
        __syncthreads();
        const float tot = (red[v] + red[128 + v]) + (red[256 + v] + red[384 + v]);
        const float coef = beta * (sm[256 + v] - tot);
        float op = 0.f;
#pragma unroll
        for (int i = 0; i < 32; ++i) { S[i] += (sm[128 + kq * 32 + i] * rk) * coef; op += S[i] * (sm[kq * 32 + i] * rq); }
        red2[kq * 128 + v] = op;
        __syncthreads();
        float o = 0.f;
        if (tid < 128) { o = (red2[v] + red2[128 + v]) + (red2[256 + v] + red2[384 + v]); const float ss = wave_sum(o * o); if (F.lane == 0) part2[F.wave] = ss; }
        __syncthreads();
        if (tid < 128) {
            const float rn = 1.0f / sqrtf((part2[0] + part2[1]) * (1.f / 128.f) + EPS);
            const float z = bf2f(prow[PC_Z + h * 128 + v]);
            O[row * D + h * 128 + v] = (bf16)f2bf(o * rn * gw * siluf(z));
        }
    }
#pragma unroll
    for (int i = 0; i < 32; ++i) Sout[(kq * 32 + i) * 128 + v] = S[i];
    if (tid < 384) { convout[ch] = x1; convout[CONVCH + ch] = x2; convout[2 * CONVCH + ch] = x3; }
    __syncthreads();
}

__device__ __forceinline__ void swa_naive_item(Frame& F, int l, int row, int kvh) {
    LAS float* scw = (LAS float*)(F.lds + RING_OFF + 8192 + F.wave * 2048);
    const bf16* PROJ = (const bf16*)(wsp(F) + WS_PROJ); bf16* O = (bf16*)(wsp(F) + WS_O);
    const int lane = F.lane;
    const bool samp = row >= MP;
    const int b = samp ? (row - MP) >> 2 : row >> 12, t = samp ? (row - MP) & 3 : row & 4095;
    const int seq0 = samp ? MP + b * 4 : b * SEQ;
    const bf16* prow = PROJ + (size_t)row * NPROJ;
    float qv[4];
#pragma unroll
    for (int g = 0; g < 4; ++g) qv[g] = bf2f(prow[PC_QB + (kvh * 4 + g) * 64 + lane]);
    const float* ck = inp(F, IN_CK) + ((size_t)(l * NB_S + b) * 128) * 128 + kvh * 64;
    const float* cv = inp(F, IN_CV) + ((size_t)(l * NB_S + b) * 128) * 128 + kvh * 64;
#pragma unroll 2
    for (int ci = 0; ci < 128; ++ci) {
        float kv; bool valid = true;
        if (!samp) { int s = t - 127 + ci; valid = s >= 0; s = valid ? s : 0; kv = bf2f(PROJ[(size_t)(seq0 + s) * NPROJ + PC_KB + kvh * 64 + lane]); }
        else { const int cidx = t + 1 + ci; kv = cidx < 128 ? ck[(size_t)cidx * 128 + lane] : bf2f(PROJ[(size_t)(seq0 + cidx - 128) * NPROJ + PC_KB + kvh * 64 + lane]); }
#pragma unroll
        for (int g = 0; g < 4; ++g) { const float s = wave_sum(qv[g] * kv); if (lane == 0) scw[g * 128 + ci] = valid ? s * 0.125f : -INFINITY; }
    }
    LDS_WAIT(); asm volatile("" ::: "memory");
#pragma unroll
    for (int g = 0; g < 4; ++g) {
        const float sk = inp(F, IN_SINKS)[l * 8 + kvh * 4 + g];
        const float s0 = scw[g * 128 + lane], s1 = scw[g * 128 + 64 + lane];
        const float mx = fmaxf(wave_max(fmaxf(s0, s1)), sk);
        const float p0 = __expf(s0 - mx), p1 = __expf(s1 - mx);
        const float den = wave_sum(p0 + p1) + __expf(sk - mx);
        scw[g * 128 + lane] = p0 / den; scw[g * 128 + 64 + lane] = p1 / den;
    }
    LDS_WAIT(); asm volatile("" ::: "memory");
    float o[4] = {0.f, 0.f, 0.f, 0.f};
#pragma unroll 2
    for (int ci = 0; ci < 128; ++ci) {
        float vv;
        if (!samp) { int s = t - 127 + ci; s = s < 0 ? 0 : s; vv = bf2f(PROJ[(size_t)(seq0 + s) * NPROJ + PC_VB + kvh * 64 + lane]); }
        else { const int cidx = t + 1 + ci; vv = cidx < 128 ? cv[(size_t)cidx * 128 + lane] : bf2f(PROJ[(size_t)(seq0 + cidx - 128) * NPROJ + PC_VB + kvh * 64 + lane]); }
#pragma unroll
        for (int g = 0; g < 4; ++g) o[g] += scw[g * 128 + ci] * vv;
    }
#pragma unroll
    for (int g = 0; g < 4; ++g) O[(size_t)row * D + 512 + (kvh * 4 + g) * 64 + lane] = (bf16)f2bf(o[g]);
    LDS_WAIT(); asm volatile("" ::: "memory");
}

__device__ __forceinline__ void mixers_rest(Frame& F, int l) {
    const bf16* PROJ = (const bf16*)(wsp(F) + WS_PROJ);
    const int wg = F.bid - 16, nwg = F.G - 16;
    for (int it = wg; it < NB_S * 4; it += nwg) {
        const int b = it >> 2, h = it & 3;
        gdn_naive_item(F, l, MP + b * T_S, T_S, h, inp(F, IN_SSSM) + ((size_t)(l * NB_S + b) * 4 + h) * 16384, inp(F, IN_SCONV) + (size_t)(l * NB_S + b) * 3 * CONVCH,
                       F.out + OSSM_S + ((size_t)(l * NB_S + b) * 4 + h) * 16384, F.out + OCONV_S + (size_t)(l * NB_S + b) * 3 * CONVCH);
    }
    for (int it = wg * NWAVES + F.wave; it < MS * 2; it += nwg * NWAVES) swa_naive_item(F, l, MP + (it >> 1), it & 1);
    const int gt = wg * NTHR + F.tid, ngt = nwg * NTHR;
    for (int i = gt; i < NB_S * 128 * 128; i += ngt) {
        const int b = i >> 14, j = (i >> 7) & 127, c = i & 127; float kk, vv;
        if (j < 124) { const size_t src = ((size_t)(l * NB_S + b) * 128 + j + 4) * 128 + c; kk = inp(F, IN_CK)[src]; vv = inp(F, IN_CV)[src]; }
        else { const bf16* prow = PROJ + (size_t)(MP + b * T_S + (j - 124)) * NPROJ; kk = bf2f(prow[PC_KB + c]); vv = bf2f(prow[PC_VB + c]); }
        F.out[OK_S + (size_t)l * NB_S * 16384 + i] = kk; F.out[OV_S + (size_t)l * NB_S * 16384 + i] = vv;
    }
}

struct Args { const float* in[23]; float* out; unsigned char* ws; int ph_lo, ph_hi; };
constexpr int NPH = 3 + 8 * DEPTH;

__global__ void __launch_bounds__(NTHR, 2) mega_fwd(Args args) {
    extern __shared__ __attribute__((aligned(16))) unsigned char lds[];
    Frame F;
    F.lds = (LAS unsigned char*)lds;
    F.tid = threadIdx.x; F.lane = F.tid & 63; F.wave = __builtin_amdgcn_readfirstlane(F.tid >> 6);
    F.G = gridDim.x; F.bid = blockIdx.x;
    if (F.tid < 23) ((LAS unsigned long long*)(F.lds + TAB_OFF))[F.tid] = (unsigned long long)args.in[F.tid];
    F.out = args.out; F.ws = args.ws;
    __syncthreads();
#if MK_ONE_LAUNCH
    cooperative_groups::grid_group grid = cooperative_groups::this_grid();
    volatile LAS unsigned* MISC = (volatile LAS unsigned*)(F.lds + MISC_OFF);
    if (F.tid < 32) MISC[F.tid] = 0u;
    __syncthreads();
    XcdBarrier bar = xcd_barrier_post((unsigned*)(args.ws + WS_CTL) + CW_BAR, MISC + 8);
#endif
    for (int ph = args.ph_lo; ph < args.ph_hi; ++ph) {
        { int t_ = threadIdx.x; asm volatile("" : "+v"(t_)); F.tid = t_; F.lane = t_ & 63; F.wave = __builtin_amdgcn_readfirstlane(t_ >> 6);
          int b_ = blockIdx.x, g_ = gridDim.x; asm volatile("" : "+s"(b_), "+s"(g_)); F.bid = b_; F.G = g_; }
        int kind, l = 0;
        if (ph < 3) kind = ph; else { l = (ph - 3) / 8; kind = 3 + (ph - 3) % 8; }
        if (kind == 0) p0_prologue(F);
        else if (kind == 2) rowpass0(F);
        else if (kind == 4) { for (int u = F.bid; u < 1024 + 256; u += F.G) { if (u < 1024) gdn_prep_unit(F, l, u); else swa_unit(F, l, u - 1024); } }
        else if (kind == 5) { if (F.bid < 16) gdn_scan(F, l, F.bid); else mixers_rest(F, l); }
        else if (kind == 7) rowpass12(F, l, 1);
        else if (kind == 10) rowpass12(F, l, 2);
        else if (kind == 3) {
            pg8::Gemm g{(const bf16*)(wsp(F) + WS_XN), (const bf16*)(wsp(F) + WS_WIN) + (size_t)l * NPROJ * D, M, NPROJ, D};
            pg8::StaticOrder S; S.init(M, NPROJ, F.G, F.bid);
            pg8::EpiBf16<0> E{(bf16*)(wsp(F) + WS_PROJ), NPROJ};
            pg8::gemm_phase<pg8::EpiBf16<0>, pg8::StaticOrder, PG8_ALIGN, PG8_SP2>(F.lds + RING_OFF, g, S, E, F.tid);
        } else if (kind == 8) {
            pg8::Gemm g{(const bf16*)(wsp(F) + WS_XN), (const bf16*)(wsp(F) + WS_WUP) + (size_t)l * FF * D, M, FF, D};
            pg8::StaticOrder S; S.init(M, FF, F.G, F.bid);
            pg8::EpiBf16<2> E{(bf16*)(wsp(F) + WS_H), FF};
            pg8::gemm_phase<pg8::EpiBf16<2>, pg8::StaticOrder, PG8_ALIGN, PG8_SP2>(F.lds + RING_OFF, g, S, E, F.tid);
        } else {
            pg8::Gemm g; pg8::EpiF32 E;
            if (kind == 1) { g = pg8::Gemm{(const bf16*)(wsp(F) + WS_SC), (const bf16*)(wsp(F) + WS_WADA), 256, DEPTH * NMOD, D}; E = pg8::EpiF32{(float*)(wsp(F) + WS_MOD), DEPTH * NMOD, inp(F, IN_BADA)}; }
            else if (kind == 6) { g = pg8::Gemm{(const bf16*)(wsp(F) + WS_O), (const bf16*)(wsp(F) + WS_WO) + (size_t)l * D * D, M, D, D}; E = pg8::EpiF32{(float*)(wsp(F) + WS_MIX), D, nullptr}; }
            else { g = pg8::Gemm{(const bf16*)(wsp(F) + WS_H), (const bf16*)(wsp(F) + WS_WDN) + (size_t)l * D * FF, M, D, FF}; E = pg8::EpiF32{(float*)(wsp(F) + WS_MIX), D, nullptr}; }
            pg8::StaticOrder S; S.init(g.M, g.N, F.G, F.bid);
            pg8::gemm_phase<pg8::EpiF32, pg8::StaticOrder, PG8_ALIGN, PG8_SP2>(F.lds + RING_OFF, g, S, E, F.tid);
        }
#if MK_ONE_LAUNCH
        if (ph + 1 < args.ph_hi) { if (ph == args.ph_lo) grid.sync(); else xcd_barrier(bar); }
#endif
    }
}

extern "C" void kernel_launch(void* const* d_in, const int* in_sizes, int n_in, void* d_out, int out_size, void* d_ws, size_t ws_size, hipStream_t stream) {
    static int grid = 0;
    if (grid == 0) {
        if (n_in != 23 || (size_t)out_size != OUT_TOTAL || ws_size < WS_END) { fprintf(stderr, "kernel_launch: unexpected shapes n_in %d out %d ws %zu\n", n_in, out_size, ws_size); grid = -1; return; }
        int dev = 0, cus = 0, per_cu = 0;
        if (hipGetDevice(&dev) != hipSuccess || hipDeviceGetAttribute(&cus, hipDeviceAttributeMultiprocessorCount, dev) != hipSuccess) { grid = -1; return; }
        if (hipFuncSetAttribute((const void*)mega_fwd, hipFuncAttributeMaxDynamicSharedMemorySize, LDS_BYTES) != hipSuccess) { fprintf(stderr, "kernel_launch: hipFuncSetAttribute failed\n"); grid = -1; return; }
        if (hipOccupancyMaxActiveBlocksPerMultiprocessor(&per_cu, (const void*)mega_fwd, NTHR, LDS_BYTES) != hipSuccess || per_cu < 1) { fprintf(stderr, "kernel_launch: occupancy query says %d\n", per_cu); per_cu = 1; }
        (void)hipGetLastError();
        grid = cus;
    }
    if (grid < 0) return;
    if (hipMemsetAsync((char*)d_ws + WS_CTL, 0, CTL_ZERO_BYTES, stream) != hipSuccess) { fprintf(stderr, "kernel_launch: memset failed\n"); return; }
    Args a{};
    for (int i = 0; i < 23; ++i) a.in[i] = (const float*)d_in[i];
    a.out = (float*)d_out; a.ws = (unsigned char*)d_ws;
#if MK_ONE_LAUNCH
    a.ph_lo = 0; a.ph_hi = NPH;
    void* kargs[] = {&a};
    hipError_t e = hipLaunchCooperativeKernel((const void*)mega_fwd, dim3(grid), dim3(NTHR), kargs, LDS_BYTES, stream);
    if (e != hipSuccess) fprintf(stderr, "cooperative launch failed: %s (grid %d)\n", hipGetErrorString(e), grid);
#else
    for (int ph = 0; ph < NPH; ++ph) {
        a.ph_lo = ph; a.ph_hi = ph + 1;
        hipLaunchKernelGGL(mega_fwd, dim3(grid), dim3(NTHR), LDS_BYTES, stream, a);
    }
#endif
}
```

```cpp
#include <hip/hip_runtime.h>
#include <hip/hip_cooperative_groups.h>
#include <cstdio>
#include <cstdint>
#include <cmath>
namespace pg8 {
#define PG8_LAS __attribute__((address_space(3)))
typedef unsigned short bf16_t;
typedef short bf16x8 __attribute__((ext_vector_type(8)));
typedef float f32x4 __attribute__((ext_vector_type(4)));
typedef unsigned u32x4 __attribute__((ext_vector_type(4)));
constexpr int BM = 256, BK = 64, HALF = 128, HTB = HALF * BK * 2  , STAGE_BYTES = 8 * HTB, NXCD = 8, WGM = 8;

__host__ __device__ __forceinline__ int lds_byte(int r, int c) { const int st = (r >> 4) * 2 + (c >> 5), rr = r & 15, cc = c & 31, ob = rr * 64 + cc * 2; return st * 1024 + (ob ^ (((ob >> 9) & 1) << 5)); }
__host__ __device__ __forceinline__ void stage_rc(int b, int& R, int& C) { const int st = b / 1024, sb = b % 1024, swz = sb ^ (((sb >> 9) & 1) << 5); R = (st >> 1) * 16 + swz / 64; C = (st & 1) * 32 + (swz % 64) / 2; }
__host__ __device__ __forceinline__ int perm32(int rho) { const int n = rho >> 4, i = rho & 15; return 8 * (i >> 2) + 4 * n + (i & 3); }

struct Unit { int pm, pn; };
struct Gemm { const bf16_t* A; const bf16_t* Bt; int M, N, K; };

struct StaticOrder {
    int nM, nN, nwg, G, c;
    __host__ __device__ void init(int M, int N, int G_, int c_) { nM = M / BM; nN = N / BM; nwg = nM * nN; G = G_; c = c_; }
    __host__ __device__ bool next(int i, Unit& u) const {
        const long L = (long)i * G + c; if (L >= nwg) return false;
        int wgid = (int)L; { const int q = nwg / NXCD, r = nwg % NXCD, xcd = wgid % NXCD, off = wgid / NXCD; wgid = (xcd < r ? xcd * (q + 1) : r * (q + 1) + (xcd - r) * q) + off; }
        const int nig = WGM * nN, gid = wgid / nig, fm = gid * WGM, gsz = (nM - fm) < WGM ? (nM - fm) : WGM;
        u.pm = fm + ((wgid % nig) % gsz); u.pn = (wgid % nig) / gsz; return true;
    }
    __device__ __forceinline__ void a_ready(const Unit&) const {}
    __device__ __forceinline__ void done(const Unit&) const {}
};


__device__ __forceinline__ unsigned cvt_pk_bf16(float lo, float hi) { unsigned r; asm volatile("v_cvt_pk_bf16_f32 %0, %1, %2" : "=v"(r) : "v"(lo), "v"(hi)); return r; }
struct EpiF32 {
    static constexpr bool PERM = false, AFTER_DRAIN = false;
    float* C; int ldc; const float* bias;
    __device__ __forceinline__ void operator()(const f32x4 (&acc)[2][2][4][2], const Unit& u, int wr, int wc, int fr, int fq) const {
        const int row0 = u.pm * BM + wr * 64 + fr, col0 = u.pn * BM + wc * 32 + 4 * fq;
        f32x4 bv[2][2];
#pragma unroll
        for (int bj = 0; bj < 2; ++bj)
#pragma unroll
            for (int n = 0; n < 2; ++n) bv[bj][n] = bias ? *(const f32x4*)(bias + col0 + bj * HALF + n * 16) : (f32x4){0.f, 0.f, 0.f, 0.f};
#pragma unroll
        for (int ai = 0; ai < 2; ++ai)
#pragma unroll
            for (int m = 0; m < 4; ++m) { float* rowp = C + (size_t)(row0 + ai * HALF + m * 16) * ldc + col0;
#pragma unroll
                for (int bj = 0; bj < 2; ++bj)
#pragma unroll
                    for (int n = 0; n < 2; ++n) *(f32x4*)(rowp + bj * HALF + n * 16) = acc[ai][bj][m][n] + bv[bj][n]; }
    }
};
template <int ACT  > struct EpiBf16 {
    static constexpr bool PERM = true, AFTER_DRAIN = false;
    bf16_t* O; int ldc;
    __device__ __forceinline__ void operator()(const f32x4 (&acc)[2][2][4][2], const Unit& u, int wr, int wc, int fr, int fq) const {
        const int row0 = u.pm * BM + wr * 64 + fr; const int col0 = u.pn * BM + wc * 32 + 8 * fq;
#pragma unroll
        for (int ai = 0; ai < 2; ++ai)
#pragma unroll
            for (int m = 0; m < 4; ++m) { bf16_t* rowp = O + (size_t)(row0 + ai * HALF + m * 16) * ldc + col0;
#pragma unroll
                for (int bj = 0; bj < 2; ++bj) { f32x4 v0 = acc[ai][bj][m][0], v1 = acc[ai][bj][m][1];
                    if (ACT == 2) {
#pragma unroll
                        for (int e = 0; e < 4; ++e) { const float a = fmaxf(v0[e], 0.f), b = fmaxf(v1[e], 0.f); v0[e] = a * a; v1[e] = b * b; } }
                    u32x4 w; w.x = cvt_pk_bf16(v0[0], v0[1]); w.y = cvt_pk_bf16(v0[2], v0[3]); w.z = cvt_pk_bf16(v1[0], v1[1]); w.w = cvt_pk_bf16(v1[2], v1[3]);
                    *(u32x4*)(rowp + bj * HALF) = w; } }
    }
};

template <class Epi, class Sched, bool ALIGN_EPI = false, bool SP2 = false>
__device__ __forceinline__ void gemm_phase(PG8_LAS unsigned char* lds, const Gemm g, const Sched& S, const Epi& E, const int tid) {
    const int wid = __builtin_amdgcn_readfirstlane(tid >> 6), lane = tid & 63, wr = wid >> 2, wc = wid & 3, fr = lane & 15, fq = lane >> 4;
    const int K = g.K, nt = K / BK;
    unsigned voffA[2], voffB[2];
#pragma unroll
    for (int i = 0; i < 2; ++i) { int R, C; stage_rc(tid * 16 + i * 8192, R, C); const int Rb = Epi::PERM ? ((R & ~31) + perm32(R & 31)) : R;
        voffA[i] = (unsigned)(R * K + C) * 2u; voffB[i] = (unsigned)(Rb * K + C) * 2u; }
    const size_t kstep = (size_t)(BK * 2);
    const size_t hstep = (size_t)HALF * K * 2;
    const size_t tstep = 2 * hstep;
    const unsigned ldsw = (unsigned)wid * 1024u;
    const int aoff = lds_byte(wr * 64 + fr, fq * 8), boff = lds_byte(wc * 32 + fr, fq * 8);
#define PG8_SA(b, h) (((b) * 2 + (h)) * HTB)
#define PG8_SB(b, h) ((4 + (b) * 2 + (h)) * HTB)
#define PG8_STAGE(bufoff, gbase, voff) do { _Pragma("unroll") for (int _i = 0; _i < 2; ++_i) \
        __builtin_amdgcn_global_load_lds((const unsigned*)((const char*)(gbase) + (voff)[_i]), (PG8_LAS unsigned*)(lds + (bufoff) + ldsw + _i * 8192), 16, 0, 0); } while (0)
#define PG8_LDA(dst, b, h) do { _Pragma("unroll") for (int m = 0; m < 4; ++m) _Pragma("unroll") for (int k = 0; k < 2; ++k) dst[m][k] = *(const PG8_LAS bf16x8*)(lds + PG8_SA(b, h) + aoff + m * 2048 + k * 1024); } while (0)
#define PG8_LDB(dst, b, h) do { _Pragma("unroll") for (int n = 0; n < 2; ++n) _Pragma("unroll") for (int k = 0; k < 2; ++k) dst[n][k] = *(const PG8_LAS bf16x8*)(lds + PG8_SB(b, h) + boff + n * 2048 + k * 1024); } while (0)
#define PG8_MMA(ai, bj, At, Bt) do { __builtin_amdgcn_s_setprio(1); _Pragma("unroll") for (int m = 0; m < 4; ++m) _Pragma("unroll") for (int n = 0; n < 2; ++n) _Pragma("unroll") for (int k = 0; k < 2; ++k) \
        acc[ai][bj][m][n] = __builtin_amdgcn_mfma_f32_16x16x32_bf16(Bt[n][k], At[m][k], acc[ai][bj][m][n], 0, 0, 0); __builtin_amdgcn_s_setprio(0); } while (0)
#define PG8_WAIT_V(n) asm volatile("s_waitcnt vmcnt(" #n ")" ::: "memory")
#define PG8_WAIT_L(n) asm volatile("s_waitcnt lgkmcnt(" #n ")" ::: "memory")
#define PG8_BAR __builtin_amdgcn_s_barrier()
#define PG8_SCHED __builtin_amdgcn_sched_barrier(0)
    Unit cur, nxt; int ui = 0;
    if (!S.next(0, cur)) return;
    f32x4 acc[2][2][4][2];
#pragma unroll
    for (int a = 0; a < 2; ++a)
#pragma unroll
        for (int b = 0; b < 2; ++b)
#pragma unroll
            for (int m = 0; m < 4; ++m)
#pragma unroll
                for (int n = 0; n < 2; ++n) acc[a][b][m][n] = (f32x4){0.f, 0.f, 0.f, 0.f};
    bf16x8 At[4][2], B0[2][2], B1[2][2];
    const char* cA = (const char*)g.A + (size_t)cur.pm * tstep; const char* cB = (const char*)g.Bt + (size_t)cur.pn * tstep;
    S.a_ready(cur);
    if constexpr (SP2) {
        PG8_STAGE(PG8_SB(0, 0), cB, voffB); PG8_STAGE(PG8_SB(0, 1), cB + hstep, voffB); PG8_STAGE(PG8_SA(0, 0), cA, voffA); PG8_STAGE(PG8_SA(0, 1), cA + hstep, voffA);
        if (wr == 1) PG8_BAR;
        PG8_WAIT_V(2); PG8_BAR;
        PG8_STAGE(PG8_SB(1, 0), cB + kstep, voffB); PG8_STAGE(PG8_SA(1, 0), cA + kstep, voffA); PG8_STAGE(PG8_SB(1, 1), cB + hstep + kstep, voffB);
        PG8_WAIT_V(6); PG8_BAR;
    } else {
        PG8_STAGE(PG8_SB(0, 0), cB, voffB); PG8_STAGE(PG8_SA(0, 0), cA, voffA); PG8_STAGE(PG8_SB(0, 1), cB + hstep, voffB); PG8_STAGE(PG8_SA(0, 1), cA + hstep, voffA);
        if (wr == 1) PG8_BAR;
        PG8_WAIT_V(4); PG8_BAR;
        PG8_STAGE(PG8_SB(1, 0), cB + kstep, voffB); PG8_STAGE(PG8_SA(1, 0), cA + kstep, voffA); PG8_STAGE(PG8_SB(1, 1), cB + hstep + kstep, voffB);
        PG8_WAIT_V(6); PG8_BAR;
    }
    for (;;) {
        const bool has_next = S.next(ui + 1, nxt);
        const char* nA = has_next ? (const char*)g.A + (size_t)nxt.pm * tstep : cA; const char* nB = has_next ? (const char*)g.Bt + (size_t)nxt.pn * tstep : cB;
        for (int t = 0; t < nt; t += 2) {
            const bool last = (t == nt - 2);
            const char* a1 = cA + (size_t)(t + 1) * kstep;
            const char* a2 = last ? nA : cA + (size_t)(t + 2) * kstep; const char* b2 = last ? nB : cB + (size_t)(t + 2) * kstep;
            const char* a3 = a2 + kstep; const char* b3 = b2 + kstep;
            if (last && has_next) S.a_ready(nxt);
            if constexpr (SP2) {
            PG8_LDB(B0, 0, 0); PG8_LDB(B1, 0, 1); PG8_SCHED; PG8_LDA(At, 0, 0); PG8_STAGE(PG8_SA(1, 1), a1 + hstep, voffA);
            PG8_WAIT_V(8); PG8_WAIT_L(0); PG8_BAR; PG8_MMA(0, 0, At, B0); PG8_MMA(0, 1, At, B1); PG8_BAR; PG8_SCHED;
            PG8_LDA(At, 0, 1); PG8_STAGE(PG8_SB(0, 0), b2, voffB); PG8_STAGE(PG8_SB(0, 1), b2 + hstep, voffB); PG8_STAGE(PG8_SA(0, 0), a2, voffA);
            PG8_WAIT_V(8); PG8_WAIT_L(0); PG8_BAR; PG8_MMA(1, 0, At, B0); PG8_MMA(1, 1, At, B1); PG8_BAR; PG8_SCHED;
            PG8_LDB(B0, 1, 0); PG8_LDB(B1, 1, 1); PG8_SCHED; PG8_LDA(At, 1, 0); PG8_STAGE(PG8_SA(0, 1), a2 + hstep, voffA);
            PG8_WAIT_V(8); PG8_WAIT_L(0); PG8_BAR; PG8_MMA(0, 0, At, B0); PG8_MMA(0, 1, At, B1); PG8_BAR; PG8_SCHED;
            PG8_LDA(At, 1, 1); PG8_STAGE(PG8_SB(1, 0), b3, voffB); PG8_STAGE(PG8_SB(1, 1), b3 + hstep, voffB); PG8_STAGE(PG8_SA(1, 0), a3, voffA);
            PG8_WAIT_V(8); PG8_WAIT_L(0); PG8_BAR; PG8_MMA(1, 0, At, B0); PG8_MMA(1, 1, At, B1); PG8_BAR; PG8_SCHED;
            } else {
            PG8_LDB(B0, 0, 0); PG8_SCHED; PG8_LDA(At, 0, 0); PG8_STAGE(PG8_SA(1, 1), a1 + hstep, voffA);
            PG8_WAIT_L(8); PG8_BAR; PG8_WAIT_L(0); PG8_MMA(0, 0, At, B0); PG8_BAR; PG8_SCHED;
            PG8_LDB(B1, 0, 1); PG8_STAGE(PG8_SB(0, 0), b2, voffB);
            PG8_BAR; PG8_WAIT_L(0); PG8_MMA(0, 1, At, B1); PG8_BAR;
            PG8_LDA(At, 0, 1); PG8_STAGE(PG8_SA(0, 0), a2, voffA);
            PG8_BAR; PG8_WAIT_L(0); PG8_MMA(1, 0, At, B0); PG8_BAR; PG8_SCHED;
            PG8_STAGE(PG8_SB(0, 1), b2 + hstep, voffB);
            PG8_WAIT_V(6); PG8_BAR; PG8_MMA(1, 1, At, B1); PG8_BAR;
            PG8_LDB(B0, 1, 0); PG8_SCHED; PG8_LDA(At, 1, 0); PG8_STAGE(PG8_SA(0, 1), a2 + hstep, voffA);
            PG8_WAIT_L(8); PG8_BAR; PG8_WAIT_L(0); PG8_MMA(0, 0, At, B0); PG8_BAR; PG8_SCHED;
            PG8_LDB(B1, 1, 1); PG8_STAGE(PG8_SB(1, 0), b3, voffB);
            PG8_BAR; PG8_WAIT_L(0); PG8_MMA(0, 1, At, B1); PG8_BAR;
            PG8_LDA(At, 1, 1); PG8_STAGE(PG8_SA(1, 0), a3, voffA);
            PG8_BAR; PG8_WAIT_L(0); PG8_MMA(1, 0, At, B0); PG8_BAR; PG8_SCHED;
            PG8_STAGE(PG8_SB(1, 1), b3 + hstep, voffB);
            PG8_WAIT_V(6); PG8_BAR; PG8_MMA(1, 1, At, B1); PG8_BAR;
            }
        }
        if constexpr (ALIGN_EPI) { if (wr == 0) PG8_BAR; }
        if constexpr (!Epi::AFTER_DRAIN) { E(acc, cur, wr, wc, fr, fq); S.done(cur); }
        if (!has_next) break;
#pragma unroll
        for (int a = 0; a < 2; ++a)
#pragma unroll
            for (int b = 0; b < 2; ++b)
#pragma unroll
                for (int m = 0; m < 4; ++m)
#pragma unroll
                    for (int n = 0; n < 2; ++n) acc[a][b][m][n] = (f32x4){0.f, 0.f, 0.f, 0.f};
        cur = nxt; cA = nA; cB = nB; ++ui;
        if constexpr (ALIGN_EPI) { if (wr == 1) PG8_BAR; }
    }
    PG8_WAIT_V(0);
    if constexpr (!ALIGN_EPI) { if (wr == 0) PG8_BAR; }
    PG8_BAR;
    if constexpr (Epi::AFTER_DRAIN) { E.fused(acc, cur, wr, wc, fr, fq, lds, wid, lane); S.done(cur); }
#undef PG8_SA
#undef PG8_SB
#undef PG8_STAGE
#undef PG8_LDA
#undef PG8_LDB
#undef PG8_MMA
#undef PG8_WAIT_V
#undef PG8_WAIT_L
#undef PG8_BAR
#undef PG8_SCHED
}
}

#ifndef PG8_SP2
#define PG8_SP2 true
#endif
#ifndef PG8_ALIGN
#define PG8_ALIGN true
#endif
#ifndef DUP_KIND
#define DUP_KIND -1
#endif
#ifndef MK_ONE_LAUNCH
#define MK_ONE_LAUNCH 1
#endif

constexpr int NWAVES = 8, NTHR = NWAVES * 64;
constexpr int D = 1024, DEPTH = 4, SEQ = 4096, NB_P = 4, NB_S = 128, T_S = 4;
constexpr int MP = NB_P * SEQ, MS = NB_S * T_S, M = MP + MS;
constexpr int NPROJ = 3072, NPROJ_REAL = 2824, FF = 4096, NMOD = 6 * D, CONVCH = 1536;
constexpr int PC_QA = 0, PC_KA = 512, PC_VA = 1024, PC_Z = 1536, PC_QB = 2048, PC_KB = 2560, PC_VB = 2688, PC_BLG = 2816, PC_ALG = 2820;
constexpr float EPS = 1e-6f;
constexpr size_t OY_P = 0, OY_S = OY_P + (size_t)MP * D, OCONV_P = OY_S + (size_t)MS * D, OSSM_P = OCONV_P + (size_t)DEPTH * NB_P * 3 * CONVCH,
    OK_P = OSSM_P + (size_t)DEPTH * NB_P * 4 * 128 * 128, OV_P = OK_P + (size_t)DEPTH * NB_P * 128 * 128, OCONV_S = OV_P + (size_t)DEPTH * NB_P * 128 * 128,
    OSSM_S = OCONV_S + (size_t)DEPTH * NB_S * 3 * CONVCH, OK_S = OSSM_S + (size_t)DEPTH * NB_S * 4 * 128 * 128, OV_S = OK_S + (size_t)DEPTH * NB_S * 128 * 128,
    OUT_TOTAL = OV_S + (size_t)DEPTH * NB_S * 128 * 128;
static_assert(OUT_TOTAL == 71639040, "output size");

constexpr size_t MiB = 1u << 20;
constexpr size_t WS_CTL = 0, CTL_ZERO_BYTES = 1 * MiB;
constexpr size_t WS_WIN = 1 * MiB, WS_WO = 25 * MiB, WS_WUP = 33 * MiB, WS_WDN = 65 * MiB;
constexpr size_t WS_SC = 97 * MiB;
constexpr size_t WS_MOD = 98 * MiB;
constexpr size_t WS_X = 122 * MiB;
constexpr size_t WS_XN = 188 * MiB;
constexpr size_t WS_PROJ = 221 * MiB;
constexpr size_t WS_O = 320 * MiB;
constexpr size_t WS_H = 221 * MiB;
constexpr size_t WS_MIX = 353 * MiB;
constexpr size_t WS_WADA = 419 * MiB;
constexpr size_t WS_END = 467 * MiB;
static_assert(WS_PROJ + (size_t)M * NPROJ * 2 <= WS_O && WS_O + (size_t)M * D * 2 <= WS_MIX && WS_H + (size_t)M * FF * 2 <= WS_MIX && WS_MIX + (size_t)M * D * 4 <= WS_WADA, "ws map");
static_assert(WS_X + (size_t)M * D * 4 <= WS_XN && WS_XN + (size_t)M * D * 2 <= WS_PROJ && WS_MOD + (size_t)256 * 24576 * 4 <= WS_X, "ws map 2");
constexpr int CW_BAR = 4096;

constexpr int RING_OFF = 0, RING_BYTES = 131072;
constexpr int LDS_BYTES = 155648;
constexpr int SCR_OFF = 148480;
constexpr int CTL_LDS_OFF = 153600, LDSCTL_OFF = CTL_LDS_OFF, MISC_OFF = LDSCTL_OFF + 320;

#define GAS __attribute__((address_space(1)))
#define LAS __attribute__((address_space(3)))
typedef unsigned short bf16;
typedef unsigned v4u __attribute__((ext_vector_type(4)));
typedef float f32x4 __attribute__((ext_vector_type(4)));
typedef GAS unsigned gu32;
#define LDS_WAIT() asm volatile("s_waitcnt lgkmcnt(0)" ::: "memory")
#define VM_WAIT() asm volatile("s_waitcnt vmcnt(0)" ::: "memory")
__device__ __forceinline__ unsigned f2bf(float f) { unsigned u = __builtin_bit_cast(unsigned, f); return (u + 0x7fffu + ((u >> 16) & 1u)) >> 16; }
__device__ __forceinline__ unsigned pk2(float lo, float hi) { return f2bf(lo) | (f2bf(hi) << 16); }
__device__ __forceinline__ float bf2f(bf16 h) { return __builtin_bit_cast(float, (unsigned)h << 16); }
__device__ __forceinline__ float bflo(unsigned w) { return __builtin_bit_cast(float, w << 16); }
__device__ __forceinline__ float bfhi(unsigned w) { return __builtin_bit_cast(float, w & 0xffff0000u); }
__device__ __forceinline__ float wave_sum(float v) {
#pragma unroll
    for (int o = 1; o < 64; o <<= 1) v += __shfl_xor(v, o);
    return v;
}
__device__ __forceinline__ float wave_max(float v) {
#pragma unroll
    for (int o = 1; o < 64; o <<= 1) v = fmaxf(v, __shfl_xor(v, o));
    return v;
}
__device__ __forceinline__ float siluf(float x) { return x / (1.f + __expf(-x)); }
__device__ __forceinline__ float sigmf(float x) { return 1.f / (1.f + __expf(-x)); }
__device__ __forceinline__ float softplusf(float x) { const float e = __expf(x); return x > 20.f ? x : (x < -10.f ? e : __logf(1.f + e)); }

#define RLX_AGENT __ATOMIC_RELAXED, __HIP_MEMORY_SCOPE_AGENT
#define XB_TMO      128
#define XB_XCNT(j)  (256  + 64 * (j))
#define XB_XSUB(j)  (1280 + 64 * (j))
#define XB_XGEN(j)  (2304 + 64 * (j))
#define XB_TOP      3328
#define XB_TOPGEN   3392
#define XCD_BAR_WORDS 3456
#define XB_SPIN_CAP (1u << 18)

__device__ __forceinline__ unsigned xb_ld(unsigned* p)              { return __hip_atomic_load(p, __ATOMIC_RELAXED, __HIP_MEMORY_SCOPE_AGENT); }
__device__ __forceinline__ unsigned xb_add(unsigned* p, unsigned v) { return __hip_atomic_fetch_add(p, v, __ATOMIC_RELAXED, __HIP_MEMORY_SCOPE_AGENT); }
__device__ __forceinline__ unsigned xb_xcc_id() { return (unsigned)__builtin_amdgcn_s_getreg((3 << 11) | 20) & 0xFu; }
#define XB_SPIN(cond, bar) do { unsigned _sp = 0; while (cond) { __builtin_amdgcn_s_sleep(1); \
    if ((++_sp & 255u) == 0u) { if (xb_ld(&(bar)[XB_TMO])) break; if (_sp > XB_SPIN_CAP) { atomicAdd(&(bar)[XB_TMO], 1u); break; } } } } while (0)

struct XcdBarrier {
    unsigned* bar; unsigned x;
    volatile LAS unsigned* st;
};

__device__ __forceinline__ XcdBarrier xcd_barrier_post(unsigned* bar, volatile LAS unsigned* st) {
    XcdBarrier b; b.bar = bar; b.x = xb_xcc_id(); b.st = st;
    if (threadIdx.x == 0) (void)xb_add(&bar[XB_XCNT(b.x)], 1u);
    return b;
}
__device__ __forceinline__ void xcd_barrier_complete(unsigned* bar, unsigned x, unsigned& nloc, unsigned& nx) {
    const unsigned G = gridDim.x * gridDim.y * gridDim.z;
    unsigned sum, cnt, mine, sp = 0u;
    for (;;) {
        sum = 0u; cnt = 0u; mine = 0u;
#pragma unroll
        for (unsigned j = 0; j < 16; ++j) { const unsigned c = xb_ld(&bar[XB_XCNT(j)]); sum += c; cnt += (c > 0u) ? 1u : 0u; mine = (j == x) ? c : mine; }
        if (sum == G) break;
        __builtin_amdgcn_s_sleep(1);
        if ((++sp & 255u) == 0u) { if (xb_ld(&bar[XB_TMO])) break; if (sp > XB_SPIN_CAP) { atomicAdd(&bar[XB_TMO], 1u); break; } }
    }
    nloc = mine > 0u ? mine : 1u; nx = cnt > 0u ? cnt : 1u;
}

__device__ __forceinline__ void xcd_barrier(const XcdBarrier& b) {
    asm volatile("s_waitcnt vmcnt(0)" ::: "memory");
    __syncthreads();
    if (threadIdx.x == 0) {
        unsigned* bar = b.bar;
        __builtin_amdgcn_s_waitcnt(0);
        unsigned nloc = b.st[0], nx = b.st[1];
        if (nloc == 0u) { xcd_barrier_complete(bar, b.x, nloc, nx); b.st[0] = nloc; b.st[1] = nx; }
        const unsigned old = xb_add(&bar[XB_XSUB(b.x)], 1u);
        const unsigned gen = old / nloc;
        if (old + 1u == (gen + 1u) * nloc) {
            __builtin_amdgcn_fence(__ATOMIC_RELEASE, "agent");
            asm volatile("s_waitcnt vmcnt(0)" ::: "memory");
            const unsigned og = xb_add(&bar[XB_TOP], 1u);
            const unsigned tg = og / nx;
            if (og + 1u == (tg + 1u) * nx) xb_add(&bar[XB_TOPGEN], 1u);
            else XB_SPIN(xb_ld(&bar[XB_TOPGEN]) == tg, bar);
            __builtin_amdgcn_fence(__ATOMIC_ACQUIRE, "agent");
            xb_add(&bar[XB_XGEN(b.x)], 1u);
            asm volatile("s_waitcnt vmcnt(0)" ::: "memory");
        } else {
            XB_SPIN(xb_ld(&bar[XB_XGEN(b.x)]) == gen, bar);
            __builtin_amdgcn_fence(__ATOMIC_ACQUIRE, "agent");
            asm volatile("s_waitcnt vmcnt(0)" ::: "memory");
        }
    }
    __syncthreads();
}

struct Frame {
    LAS unsigned char* lds;
    int tid, lane, wave, G, bid;
    float* out; unsigned char* ws;
};
__device__ __forceinline__ unsigned char* wsp(const Frame& F) { unsigned char* p = F.ws; asm volatile("" : "+s"(p)); return p; }
__device__ __forceinline__ float* outp(const Frame& F) { float* p = F.out; asm volatile("" : "+s"(p)); return p; }
__device__ __forceinline__ LAS unsigned char* vlds(const Frame& F) { unsigned a = (unsigned)(__UINTPTR_TYPE__)F.lds; asm volatile("" : "+v"(a)); return (LAS unsigned char*)(__UINTPTR_TYPE__)a; }
constexpr int TAB_OFF = LDSCTL_OFF + 1024;
__device__ __forceinline__ const float* inp(const Frame& F, int i) {
    const unsigned long long v = ((const LAS unsigned long long*)(F.lds + TAB_OFF))[i];
    const unsigned lo = __builtin_amdgcn_readfirstlane((unsigned)v), hi = __builtin_amdgcn_readfirstlane((unsigned)(v >> 32));
    return (const float*)(((unsigned long long)hi << 32) | lo);
}
#define IN_XP 0
#define IN_XS 1
#define IN_SCONV 2
#define IN_SSSM 3
#define IN_CK 4
#define IN_CV 5
#define IN_CP 6
#define IN_CS 7
#define IN_GPREM 8
#define IN_GPOSTM 9
#define IN_GPREF 10
#define IN_GPOSTF 11
#define IN_WADA 12
#define IN_BADA 13
#define IN_WIN 14
#define IN_CONVW 15
#define IN_ALOG 16
#define IN_DTB 17
#define IN_GDNW 18
#define IN_SINKS 19
#define IN_WO 20
#define IN_WUP 21
#define IN_WDN 22

template <int MAPKIND  >
__device__ __forceinline__ void p0_transpose_item(const float* W, int K, int N, int Ndst, bf16* WT, LAS float* scr, int item, int lane) {
    const int nblk = Ndst / 32, kb = item / nblk, nb = item % nblk, k0 = 64 * kb, n0 = 32 * nb;
    const int nd = n0 + (lane & 31);
    int ns = nd;
    if (MAPKIND == 1) { ns = nd < 2048 ? nd : (nd < 2816 ? nd + 8 : (nd < 2824 ? nd - 768 : -1)); }
#pragma unroll 8
    for (int i = 0; i < 32; ++i) { const int kk = 2 * i + (lane >> 5); scr[kk * 33 + (lane & 31)] = (ns >= 0) ? W[(size_t)(k0 + kk) * N + ns] : 0.f; }
    LDS_WAIT(); asm volatile("" ::: "memory");
    const int c = lane & 7;
#pragma unroll
    for (int j = 0; j < 4; ++j) { const int n = (lane >> 3) + 8 * j; const LAS float* s = scr + (8 * c) * 33 + n;
        v4u o; o.x = pk2(s[0 * 33], s[1 * 33]); o.y = pk2(s[2 * 33], s[3 * 33]); o.z = pk2(s[4 * 33], s[5 * 33]); o.w = pk2(s[6 * 33], s[7 * 33]);
        *(GAS v4u*)(WT + (size_t)(n0 + n) * K + k0 + 8 * c) = o; }
    LDS_WAIT(); asm volatile("" ::: "memory");
}

__device__ __forceinline__ void p0_prologue(Frame& F) {
    LAS float* scr = (LAS float*)(F.lds + RING_OFF + F.wave * 16384);
    const int gw = F.bid * NWAVES + F.wave, NGW = F.G * NWAVES;
    constexpr int I_IN = (D / 64) * (NPROJ / 32), I_O = (D / 64) * (D / 32), I_UP = (D / 64) * (FF / 32), I_DN = (FF / 64) * (D / 32), I_ADA = (D / 64) * (NMOD / 32);
    constexpr int PER_L = I_IN + I_O + I_UP + I_DN + I_ADA;
    for (int it = gw; it < DEPTH * PER_L; it += NGW) {
        const int l = it / PER_L; int r = it % PER_L;
        if (r < I_IN) { p0_transpose_item<1>(inp(F, IN_WIN) + (size_t)l * D * NPROJ_REAL, D, NPROJ_REAL, NPROJ, (bf16*)(wsp(F) + WS_WIN) + (size_t)l * NPROJ * D, scr, r, F.lane); continue; } r -= I_IN;
        if (r < I_O) { p0_transpose_item<0>(inp(F, IN_WO) + (size_t)l * D * D, D, D, D, (bf16*)(wsp(F) + WS_WO) + (size_t)l * D * D, scr, r, F.lane); continue; } r -= I_O;
        if (r < I_UP) { p0_transpose_item<0>(inp(F, IN_WUP) + (size_t)l * D * FF, D, FF, FF, (bf16*)(wsp(F) + WS_WUP) + (size_t)l * FF * D, scr, r, F.lane); continue; } r -= I_UP;
        if (r < I_DN) { p0_transpose_item<0>(inp(F, IN_WDN) + (size_t)l * FF * D, FF, D, D, (bf16*)(wsp(F) + WS_WDN) + (size_t)l * D * FF, scr, r, F.lane); continue; } r -= I_DN;
        p0_transpose_item<0>(inp(F, IN_WADA) + (size_t)l * D * NMOD, D, NMOD, NMOD, (bf16*)(wsp(F) + WS_WADA) + (size_t)l * NMOD * D, scr, r, F.lane);
    }
    bf16* SC = (bf16*)(wsp(F) + WS_SC);
    for (int i = F.bid * NTHR + F.tid; i < 256 * D; i += F.G * NTHR) {
        const int r = i >> 10, c = i & 1023; float v = 0.f;
        if (r < NB_P) v = siluf(inp(F, IN_CP)[r * D + c]); else if (r < NB_P + NB_S) v = siluf(inp(F, IN_CS)[(r - NB_P) * D + c]);
        SC[i] = (bf16)f2bf(v);
    }
}

__device__ __forceinline__ const float* modp(Frame& F, int row, int l, int j) {
    const int mrow = row < MP ? (row >> 12) : NB_P + ((row - MP) >> 2);
    return (const float*)(wsp(F) + WS_MOD) + (size_t)mrow * (DEPTH * NMOD) + l * NMOD + j * D;
}
__device__ __forceinline__ void modnorm_store(Frame& F, const f32x4 (&v)[4], const float* g, const float* scale, const float* shift, bf16* orow) {
    float s = 0.f;
#pragma unroll
    for (int j = 0; j < 4; ++j) s += (v[j].x * v[j].x + v[j].y * v[j].y) + (v[j].z * v[j].z + v[j].w * v[j].w);
    const float rs = 1.0f / sqrtf(wave_sum(s) * (1.f / D) + EPS);
    GAS unsigned long long* o8 = (GAS unsigned long long*)orow + F.lane;
#pragma unroll
    for (int j = 0; j < 4; ++j) {
        const f32x4 gg = ((const f32x4*)g)[F.lane + 64 * j], sc = ((const f32x4*)scale)[F.lane + 64 * j], sh = ((const f32x4*)shift)[F.lane + 64 * j];
        const f32x4 h = (v[j] * rs) * gg * (sc + 1.0f) + sh;
        o8[64 * j] = (unsigned long long)pk2(h.x, h.y) | ((unsigned long long)pk2(h.z, h.w) << 32);
    }
}
__device__ __forceinline__ const float* xin_row(Frame& F, int row) { return row < MP ? inp(F, IN_XP) + (size_t)row * D : inp(F, IN_XS) + (size_t)(row - MP) * D; }
__device__ __forceinline__ void rowpass0(Frame& F) {
    const int gw = F.bid * NWAVES + F.wave, NGW = F.G * NWAVES;
    for (int row = gw; row < M; row += NGW) {
        const f32x4* xr = (const f32x4*)xin_row(F, row) + F.lane; f32x4 v[4];
#pragma unroll
        for (int j = 0; j < 4; ++j) v[j] = xr[64 * j];
        modnorm_store(F, v, inp(F, IN_GPREM), modp(F, row, 0, 1), modp(F, row, 0, 0), (bf16*)(wsp(F) + WS_XN) + (size_t)row * D);
    }
}
__device__ __forceinline__ void rowpass12(Frame& F, int l, int kind) {
    const int gw = F.bid * NWAVES + F.wave, NGW = F.G * NWAVES;
    float* X = (float*)(wsp(F) + WS_X); const float* MIX = (const float*)(wsp(F) + WS_MIX);
    for (int row = gw; row < M; row += NGW) {
        const float* xsrc = (l == 0 && kind == 1) ? xin_row(F, row) : X + (size_t)row * D;
        const f32x4* xr = (const f32x4*)xsrc + F.lane; const f32x4* mr = (const f32x4*)(MIX + (size_t)row * D) + F.lane;
        f32x4 x[4], m[4]; float s = 0.f;
#pragma unroll
        for (int j = 0; j < 4; ++j) { x[j] = xr[64 * j]; m[j] = mr[64 * j]; s += (m[j].x * m[j].x + m[j].y * m[j].y) + (m[j].z * m[j].z + m[j].w * m[j].w); }
        const float rs = 1.0f / sqrtf(wave_sum(s) * (1.f / D) + EPS);
        const float* gpost = inp(F, kind == 1 ? IN_GPOSTM : IN_GPOSTF) + l * D; const float* gate = modp(F, row, l, kind == 1 ? 2 : 5);
#pragma unroll
        for (int j = 0; j < 4; ++j) { const f32x4 gp = ((const f32x4*)gpost)[F.lane + 64 * j], gt = ((const f32x4*)gate)[F.lane + 64 * j]; x[j] = x[j] + gt * ((m[j] * rs) * gp); }
        const bool fin = (kind == 2 && l == DEPTH - 1);
        float* xdst = fin ? (row < MP ? outp(F) + OY_P + (size_t)row * D : outp(F) + OY_S + (size_t)(row - MP) * D) : X + (size_t)row * D;
#pragma unroll
        for (int j = 0; j < 4; ++j) ((f32x4*)xdst)[F.lane + 64 * j] = x[j];
        if (!fin) {
            if (kind == 1) modnorm_store(F, x, inp(F, IN_GPREF) + l * D, modp(F, row, l, 4), modp(F, row, l, 3), (bf16*)(wsp(F) + WS_XN) + (size_t)row * D);
            else modnorm_store(F, x, inp(F, IN_GPREM) + (l + 1) * D, modp(F, row, l + 1, 1), modp(F, row, l + 1, 0), (bf16*)(wsp(F) + WS_XN) + (size_t)row * D);
        }
    }
}

typedef short bf16x8 __attribute__((ext_vector_type(8)));
typedef float f32x16 __attribute__((ext_vector_type(16)));
typedef float f32x2_t __attribute__((ext_vector_type(2))); typedef __bf16 bf16x2_t __attribute__((ext_vector_type(2)));
typedef unsigned v2u __attribute__((ext_vector_type(2)));
#define MFMA32(a, b, c) __builtin_amdgcn_mfma_f32_32x32x16_bf16((a), (b), (c), 0, 0, 0)
__device__ __forceinline__ unsigned cvtpk(float lo, float hi) { f32x2_t v = {lo, hi}; bf16x2_t b = __builtin_convertvector(v, bf16x2_t); return __builtin_bit_cast(unsigned, b); }
__device__ __forceinline__ int crow(int i, int h) { return (i & 3) + 8 * (i >> 2) + 4 * h; }
__device__ __forceinline__ bf16x8 pack8(const f32x16& x, int s, float sc) {
    v4u p; p.x = cvtpk(x[8 * s] * sc, x[8 * s + 1] * sc); p.y = cvtpk(x[8 * s + 2] * sc, x[8 * s + 3] * sc); p.z = cvtpk(x[8 * s + 4] * sc, x[8 * s + 5] * sc); p.w = cvtpk(x[8 * s + 6] * sc, x[8 * s + 7] * sc);
    return __builtin_bit_cast(bf16x8, p);
}
constexpr size_t WS_GDN = 353 * MiB;
constexpr int GDN_CH_BYTES = 73728, GDN_STAGE_BYTES = 57344;
constexpr int GO_NW = 0, GO_QG = 16384, GO_KGT = 32768, GO_ATT = 49152, GO_U = 57344;
constexpr size_t WS_GL = WS_GDN + (size_t)1024 * GDN_CH_BYTES;
static_assert(WS_GL + 4096 <= WS_END, "gdn region");
constexpr int PL_KN = 0, PL_QN = 17408, PL_KBGT = 34816, PL_VBT = 53248, PL_KGT = 71680, PL_QG = 89088, PL_L = 105984, PL_T = 122368, PL_VEC = SCR_OFF;
static_assert(PL_T + 64 * 144 <= SCR_OFF, "prep lds");

__device__ __forceinline__ void gdn_prep_unit(Frame& F, int l, int unit) {
    const int b = unit >> 8, h = (unit >> 6) & 3, c = unit & 63, t0 = c * 64, R0 = b * SEQ + t0;
    int tid_ = F.tid; asm volatile("" : "+v"(tid_));
    const int tid = tid_, lane = tid & 63, wave = F.wave, r = lane & 31, hh = lane >> 5;
    const bf16* PROJ = (const bf16*)(wsp(F) + WS_PROJ);
    unsigned char* gout = wsp(F) + WS_GDN + (size_t)unit * GDN_CH_BYTES;
    LAS unsigned char* lds = vlds(F);
    LAS float* VEC = (LAS float*)(lds + PL_VEC);
    __syncthreads();
    if (wave == 0) {
        const bf16* prow = PROJ + (size_t)(R0 + lane) * NPROJ;
        const float bl = bf2f(prow[PC_BLG + h]), al = bf2f(prow[PC_ALG + h]);
        float g = -__expf(inp(F, IN_ALOG)[l * 4 + h]) * softplusf(al + inp(F, IN_DTB)[l * 4 + h]);
#pragma unroll
        for (int o = 1; o < 64; o <<= 1) { const float v = __shfl_up(g, o); if (lane >= o) g += v; }
        const float glast = __shfl(g, 63);
        VEC[lane] = g; VEC[64 + lane] = sigmf(bl); VEC[128 + lane] = __expf(g); VEC[192 + lane] = __expf(glast - g);
        if (lane == 0) ((float*)(wsp(F) + WS_GL))[unit] = __expf(glast);
    }
    __syncthreads();
    {
        const int t = tid >> 3, d0 = (tid & 7) * 16;
        const float beta = VEC[64 + t], eg = VEC[128 + t], ek = VEC[192 + t];
        const float* cwb = inp(F, IN_CONVW) + (size_t)l * 4 * CONVCH;
#pragma unroll 1
        for (int m = 0; m < 3; ++m) {
            const int col = m * 512 + h * 128 + d0;
            float acc[16], xl[16];
#pragma unroll
            for (int e = 0; e < 16; ++e) { acc[e] = 0.f; xl[e] = 0.f; }
#pragma unroll
            for (int i = 0; i < 4; ++i) {
                const int tt = t0 + t - 3 + i;
                v4u w0 = (v4u){0u, 0u, 0u, 0u}, w1 = w0;
                if (tt >= 0) { const v4u* p = (const v4u*)(PROJ + (size_t)(b * SEQ + tt) * NPROJ + col); w0 = p[0]; w1 = p[1]; }
                const f32x4* cp = (const f32x4*)(cwb + i * CONVCH + col);
                const f32x4 c0 = cp[0], c1 = cp[1], c2 = cp[2], c3 = cp[3];
                float x[16];
                x[0] = bflo(w0.x); x[1] = bfhi(w0.x); x[2] = bflo(w0.y); x[3] = bfhi(w0.y); x[4] = bflo(w0.z); x[5] = bfhi(w0.z); x[6] = bflo(w0.w); x[7] = bfhi(w0.w);
                x[8] = bflo(w1.x); x[9] = bfhi(w1.x); x[10] = bflo(w1.y); x[11] = bfhi(w1.y); x[12] = bflo(w1.z); x[13] = bfhi(w1.z); x[14] = bflo(w1.w); x[15] = bfhi(w1.w);
                acc[0] += c0.x * x[0]; acc[1] += c0.y * x[1]; acc[2] += c0.z * x[2]; acc[3] += c0.w * x[3];
                acc[4] += c1.x * x[4]; acc[5] += c1.y * x[5]; acc[6] += c1.z * x[6]; acc[7] += c1.w * x[7];
                acc[8] += c2.x * x[8]; acc[9] += c2.y * x[9]; acc[10] += c2.z * x[10]; acc[11] += c2.w * x[11];
                acc[12] += c3.x * x[12]; acc[13] += c3.y * x[13]; acc[14] += c3.z * x[14]; acc[15] += c3.w * x[15];
                if (i == 3) {
#pragma unroll
                    for (int e = 0; e < 16; ++e) xl[e] = x[e];
                }
            }
            if (c == 63 && t >= 61) {
                float* co = outp(F) + OCONV_P + ((size_t)(l * NB_P + b) * 3 + (t - 61)) * CONVCH + col;
#pragma unroll
                for (int e = 0; e < 16; ++e) co[e] = xl[e];
            }
            float ss = 0.f;
#pragma unroll
            for (int e = 0; e < 16; ++e) { acc[e] = siluf(acc[e]); ss += acc[e] * acc[e]; }
            ss += __shfl_xor(ss, 1); ss += __shfl_xor(ss, 2); ss += __shfl_xor(ss, 4);
            const float rs = 1.0f / sqrtf(ss + EPS);
            if (m == 0) {
                const float sq = rs * 0.08838834764831845f, sg = sq * eg;
                v4u a0, a1, g0, g1;
                a0.x = cvtpk(acc[0] * sq, acc[1] * sq); a0.y = cvtpk(acc[2] * sq, acc[3] * sq); a0.z = cvtpk(acc[4] * sq, acc[5] * sq); a0.w = cvtpk(acc[6] * sq, acc[7] * sq);
                a1.x = cvtpk(acc[8] * sq, acc[9] * sq); a1.y = cvtpk(acc[10] * sq, acc[11] * sq); a1.z = cvtpk(acc[12] * sq, acc[13] * sq); a1.w = cvtpk(acc[14] * sq, acc[15] * sq);
                g0.x = cvtpk(acc[0] * sg, acc[1] * sg); g0.y = cvtpk(acc[2] * sg, acc[3] * sg); g0.z = cvtpk(acc[4] * sg, acc[5] * sg); g0.w = cvtpk(acc[6] * sg, acc[7] * sg);
                g1.x = cvtpk(acc[8] * sg, acc[9] * sg); g1.y = cvtpk(acc[10] * sg, acc[11] * sg); g1.z = cvtpk(acc[12] * sg, acc[13] * sg); g1.w = cvtpk(acc[14] * sg, acc[15] * sg);
                *(LAS v4u*)(lds + PL_QN + t * 272 + d0 * 2) = a0; *(LAS v4u*)(lds + PL_QN + t * 272 + d0 * 2 + 16) = a1;
                *(LAS v2u*)(lds + PL_QG + t * 264 + d0 * 2) = (v2u){g0.x, g0.y}; *(LAS v2u*)(lds + PL_QG + t * 264 + d0 * 2 + 8) = (v2u){g0.z, g0.w};
                *(LAS v2u*)(lds + PL_QG + t * 264 + d0 * 2 + 16) = (v2u){g1.x, g1.y}; *(LAS v2u*)(lds + PL_QG + t * 264 + d0 * 2 + 24) = (v2u){g1.z, g1.w};
            } else if (m == 1) {
                v4u a0, a1;
                a0.x = cvtpk(acc[0] * rs, acc[1] * rs); a0.y = cvtpk(acc[2] * rs, acc[3] * rs); a0.z = cvtpk(acc[4] * rs, acc[5] * rs); a0.w = cvtpk(acc[6] * rs, acc[7] * rs);
                a1.x = cvtpk(acc[8] * rs, acc[9] * rs); a1.y = cvtpk(acc[10] * rs, acc[11] * rs); a1.z = cvtpk(acc[12] * rs, acc[13] * rs); a1.w = cvtpk(acc[14] * rs, acc[15] * rs);
                *(LAS v4u*)(lds + PL_KN + t * 272 + d0 * 2) = a0; *(LAS v4u*)(lds + PL_KN + t * 272 + d0 * 2 + 16) = a1;
                const float sb = rs * beta * eg, sk = rs * ek;
#pragma unroll
                for (int e = 0; e < 16; ++e) {
                    *(LAS bf16*)(lds + PL_KBGT + (d0 + e) * 144 + t * 2) = (bf16)f2bf(acc[e] * sb);
                    *(LAS bf16*)(lds + PL_KGT + (d0 + e) * 136 + t * 2) = (bf16)f2bf(acc[e] * sk);
                }
            } else {
#pragma unroll
                for (int e = 0; e < 16; ++e) *(LAS bf16*)(lds + PL_VBT + (d0 + e) * 144 + t * 2) = (bf16)f2bf(acc[e] * beta);
            }
        }
    }
    __syncthreads();
    if (wave < 6) {
        const bool isqk = wave >= 3; const int tsel = isqk ? wave - 3 : wave;
        const int ta = isqk ? (tsel == 2 ? 1 : 0) : (tsel == 0 ? 0 : 1);
        const int tb = isqk ? (tsel == 0 ? 0 : 1) : (tsel == 2 ? 1 : 0);
        const int boff = isqk ? PL_QN : PL_KN;
        f32x16 acc;
#pragma unroll
        for (int i = 0; i < 16; ++i) acc[i] = 0.f;
#pragma unroll
        for (int s = 0; s < 8; ++s) {
            const bf16x8 a = *(const LAS bf16x8*)(lds + PL_KN + (32 * ta + r) * 272 + (16 * s + 8 * hh) * 2);
            const bf16x8 bb = *(const LAS bf16x8*)(lds + boff + (32 * tb + r) * 272 + (16 * s + 8 * hh) * 2);
            acc = MFMA32(a, bb, acc);
        }
        if (!isqk) {
            const int j = 32 * tb + r; const float gj = VEC[j];
#pragma unroll
            for (int i2 = 0; i2 < 16; ++i2) { const int i = 32 * ta + crow(i2, hh);
                const float v = (i > j) ? VEC[64 + i] * acc[i2] * __expf(fminf(VEC[i] - gj, 0.f)) : 0.f;
                ((LAS float*)(lds + PL_L))[i * 64 + j] = v; }
        } else {
            const int cq = 32 * tb + r; const float gq = VEC[cq];
#pragma unroll
            for (int i2 = 0; i2 < 16; ++i2) { const int cp = 32 * ta + crow(i2, hh);
                acc[i2] = (cq >= cp) ? acc[i2] * __expf(fminf(gq - VEC[cp], 0.f)) : 0.f; }
#pragma unroll
            for (int s = 0; s < 2; ++s) *(v4u*)(gout + GO_ATT + ((tb * 4 + 2 * ta + s) * 64 + lane) * 16) = __builtin_bit_cast(v4u, pack8(acc, s, 1.f));
        }
    } else if (wave == 6) {
#pragma unroll
        for (int s = 0; s < 2; ++s) *(v4u*)(gout + GO_ATT + ((0 * 4 + 2 * 1 + s) * 64 + lane) * 16) = (v4u){0u, 0u, 0u, 0u};
    }
    __syncthreads();
    if (wave == 0) {
        float tc[64];
        const LAS float* Lm = (const LAS float*)(lds + PL_L);
#pragma unroll
        for (int i = 0; i < 64; ++i) {
            float a = (i == lane) ? 1.f : 0.f;
#pragma unroll
            for (int m = 0; m < i; ++m) a -= Lm[i * 64 + m] * tc[m];
            tc[i] = a;
        }
#pragma unroll
        for (int i = 0; i < 64; ++i) *(LAS bf16*)(lds + PL_T + i * 144 + lane * 2) = (bf16)f2bf(tc[i]);
    } else {
        for (int f = wave - 1; f < 32; f += 7) {
            if (f < 16) {
                const int ct = f >> 3, kk = f & 7, k0 = 32 * (kk >> 1) + 16 * (kk & 1) + 4 * hh;
                const v2u lo = *(const LAS v2u*)(lds + PL_QG + (32 * ct + r) * 264 + k0 * 2), hi = *(const LAS v2u*)(lds + PL_QG + (32 * ct + r) * 264 + (k0 + 8) * 2);
                *(v4u*)(gout + GO_QG + (f * 64 + lane) * 16) = (v4u){lo.x, lo.y, hi.x, hi.y};
            } else {
                const int g = f - 16, rt = g >> 2, k2 = g & 3, c0 = 32 * (k2 >> 1) + 16 * (k2 & 1) + 4 * hh;
                const v2u lo = *(const LAS v2u*)(lds + PL_KGT + (32 * rt + r) * 136 + c0 * 2), hi = *(const LAS v2u*)(lds + PL_KGT + (32 * rt + r) * 136 + (c0 + 8) * 2);
                *(v4u*)(gout + GO_KGT + (g * 64 + lane) * 16) = (v4u){lo.x, lo.y, hi.x, hi.y};
            }
        }
    }
    __syncthreads();
    {
        const int rt = wave >> 1, ct = wave & 1;
        f32x16 acc;
#pragma unroll
        for (int i = 0; i < 16; ++i) acc[i] = 0.f;
#pragma unroll
        for (int s = 0; s < 4; ++s) {
            const bf16x8 a = *(const LAS bf16x8*)(lds + PL_KBGT + (32 * rt + r) * 144 + (16 * s + 8 * hh) * 2);
            const bf16x8 bb = *(const LAS bf16x8*)(lds + PL_T + (32 * ct + r) * 144 + (16 * s + 8 * hh) * 2);
            acc = MFMA32(a, bb, acc);
        }
#pragma unroll
        for (int s = 0; s < 2; ++s) *(v4u*)(gout + GO_NW + ((ct * 8 + 2 * rt + s) * 64 + lane) * 16) = __builtin_bit_cast(v4u, pack8(acc, s, -1.f));
    }
    {
        const int ct = wave >> 2, wv = wave & 3;
        f32x16 acc;
#pragma unroll
        for (int i = 0; i < 16; ++i) acc[i] = 0.f;
#pragma unroll
        for (int s = 0; s < 4; ++s) {
            const bf16x8 a = *(const LAS bf16x8*)(lds + PL_T + (32 * ct + r) * 144 + (16 * s + 8 * hh) * 2);
            const bf16x8 bb = *(const LAS bf16x8*)(lds + PL_VBT + (32 * wv + r) * 144 + (16 * s + 8 * hh) * 2);
            acc = MFMA32(a, bb, acc);
        }
        v4u* up = (v4u*)(gout + GO_U + ((wv * 2 + ct) * 64 + lane) * 32);
        up[0] = __builtin_bit_cast(v4u, pack8(acc, 0, 1.f)); up[1] = __builtin_bit_cast(v4u, pack8(acc, 1, 1.f));
    }
}

#define LBAR() do { asm volatile("s_waitcnt lgkmcnt(0)" ::: "memory"); __builtin_amdgcn_s_barrier(); asm volatile("" ::: "memory"); } while (0)
constexpr int SL_STAGE1 = 57344, SL_O0 = 114688, SL_O1 = 131584, SL_OSTRIDE = 264;
static_assert(SL_O1 + 64 * SL_OSTRIDE <= CTL_LDS_OFF, "scan lds");

struct USet { v4u a0, b0, a1, b1; };
__device__ __forceinline__ void uset_load(USet& u, const unsigned char* gch, int wave, int lane) {
    const v4u* up = (const v4u*)(gch + GO_U + ((wave * 2 + 0) * 64 + lane) * 32); u.a0 = up[0]; u.b0 = up[1];
    const v4u* uq = (const v4u*)(gch + GO_U + ((wave * 2 + 1) * 64 + lane) * 32); u.a1 = uq[0]; u.b1 = uq[1];
}
__device__ __forceinline__ void unpack16(f32x16& v, const v4u& a, const v4u& b) {
    v[0] = bflo(a.x); v[1] = bfhi(a.x); v[2] = bflo(a.y); v[3] = bfhi(a.y); v[4] = bflo(a.z); v[5] = bfhi(a.z); v[6] = bflo(a.w); v[7] = bfhi(a.w);
    v[8] = bflo(b.x); v[9] = bfhi(b.x); v[10] = bflo(b.y); v[11] = bfhi(b.y); v[12] = bflo(b.z); v[13] = bfhi(b.z); v[14] = bflo(b.w); v[15] = bfhi(b.w);
}
__device__ __forceinline__ void scan_step(int c, USet& U, f32x16& S0, f32x16& S1, f32x16& S2, f32x16& S3, float glc, LAS unsigned char* lds, const unsigned char* gin, int wave, int lane, int r, int hh) {
    LAS unsigned char* st = lds + (c & 1) * SL_STAGE1;
    f32x16 vn0, vn1, o0, o1;
    unpack16(vn0, U.a0, U.b0); unpack16(vn1, U.a1, U.b1);
#pragma unroll
    for (int i = 0; i < 16; ++i) { o0[i] = 0.f; o1[i] = 0.f; }
    if (c + 2 < 64) uset_load(U, gin + (size_t)(c + 2) * GDN_CH_BYTES, wave, lane);
#pragma unroll
    for (int kk = 0; kk < 8; ++kk) {
        const bf16x8 sb = pack8(kk < 2 ? S0 : (kk < 4 ? S1 : (kk < 6 ? S2 : S3)), kk & 1, 1.f);
        const bf16x8 a0 = *(const LAS bf16x8*)(st + GO_NW + ((0 * 8 + kk) * 64 + lane) * 16), a1 = *(const LAS bf16x8*)(st + GO_NW + ((1 * 8 + kk) * 64 + lane) * 16);
        const bf16x8 q0 = *(const LAS bf16x8*)(st + GO_QG + ((0 * 8 + kk) * 64 + lane) * 16), q1 = *(const LAS bf16x8*)(st + GO_QG + ((1 * 8 + kk) * 64 + lane) * 16);
        vn0 = MFMA32(a0, sb, vn0); vn1 = MFMA32(a1, sb, vn1);
        o0 = MFMA32(q0, sb, o0); o1 = MFMA32(q1, sb, o1);
    }
    bf16x8 vb[4];
    vb[0] = pack8(vn0, 0, 1.f); vb[1] = pack8(vn0, 1, 1.f); vb[2] = pack8(vn1, 0, 1.f); vb[3] = pack8(vn1, 1, 1.f);
#pragma unroll
    for (int i = 0; i < 16; ++i) { S0[i] *= glc; S1[i] *= glc; S2[i] *= glc; S3[i] *= glc; }
#pragma unroll
    for (int k2 = 0; k2 < 4; ++k2) {
        const bf16x8 t1 = *(const LAS bf16x8*)(st + GO_ATT + ((1 * 4 + k2) * 64 + lane) * 16);
        if (k2 < 2) { const bf16x8 t0 = *(const LAS bf16x8*)(st + GO_ATT + ((0 * 4 + k2) * 64 + lane) * 16); o0 = MFMA32(t0, vb[k2], o0); }
        o1 = MFMA32(t1, vb[k2], o1);
        const bf16x8 g0 = *(const LAS bf16x8*)(st + GO_KGT + ((0 * 4 + k2) * 64 + lane) * 16), g1 = *(const LAS bf16x8*)(st + GO_KGT + ((1 * 4 + k2) * 64 + lane) * 16);
        const bf16x8 g2 = *(const LAS bf16x8*)(st + GO_KGT + ((2 * 4 + k2) * 64 + lane) * 16), g3 = *(const LAS bf16x8*)(st + GO_KGT + ((3 * 4 + k2) * 64 + lane) * 16);
        S0 = MFMA32(g0, vb[k2], S0); S1 = MFMA32(g1, vb[k2], S1); S2 = MFMA32(g2, vb[k2], S2); S3 = MFMA32(g3, vb[k2], S3);
    }
    LAS unsigned char* ot = lds + ((c & 1) ? SL_O1 : SL_O0) + (32 * wave + r) * 2;
#pragma unroll
    for (int i = 0; i < 16; i += 2) {
        const unsigned p0 = cvtpk(o0[i], o0[i + 1]), p1 = cvtpk(o1[i], o1[i + 1]);
        *(LAS bf16*)(ot + crow(i, hh) * SL_OSTRIDE) = (bf16)(p0 & 0xffffu); *(LAS bf16*)(ot + crow(i + 1, hh) * SL_OSTRIDE) = (bf16)(p0 >> 16);
        *(LAS bf16*)(ot + (32 + crow(i, hh)) * SL_OSTRIDE) = (bf16)(p1 & 0xffffu); *(LAS bf16*)(ot + (32 + crow(i + 1, hh)) * SL_OSTRIDE) = (bf16)(p1 >> 16);
    }
    LBAR();
}
struct LSet { v4u t[14]; };
__device__ __forceinline__ void lset_load(LSet& s, const unsigned char* gch, int lt) {
    const v4u* src = (const v4u*)gch + lt;
#pragma unroll
    for (int j = 0; j < 14; ++j) s.t[j] = src[j * 256];
}
__device__ __forceinline__ void lset_store(const LSet& s, LAS unsigned char* dst, int lt) {
#pragma unroll
    for (int j = 0; j < 14; ++j) *(LAS v4u*)(dst + (j * 256 + lt) * 16) = s.t[j];
}
__device__ __forceinline__ void loader_step(int c, LSet& L, v4u (&zr)[4], LAS unsigned char* lds, const unsigned char* gin, const bf16* PROJ, bf16* O, int b, int h, int lt) {
    const int orow = lt >> 2, oq = lt & 3;
    if (c + 1 < 64) lset_store(L, lds + ((c + 1) & 1) * SL_STAGE1, lt);
    if (c >= 1 && c <= 64) {
        const int cc = c - 1; const LAS unsigned char* ot = lds + ((cc & 1) ? SL_O1 : SL_O0) + orow * SL_OSTRIDE + oq * 64;
        const size_t row = (size_t)(b * SEQ + cc * 64 + orow);
        float ov[32]; float ss = 0.f;
#pragma unroll
        for (int j = 0; j < 8; ++j) { const v2u w = *(const LAS v2u*)(ot + j * 8); ov[4 * j] = bflo(w.x); ov[4 * j + 1] = bfhi(w.x); ov[4 * j + 2] = bflo(w.y); ov[4 * j + 3] = bfhi(w.y); }
#pragma unroll
        for (int e = 0; e < 32; ++e) ss += ov[e] * ov[e];
        ss += __shfl_xor(ss, 1); ss += __shfl_xor(ss, 2);
        const float rn = 1.0f / sqrtf(ss * (1.f / 128.f) + EPS);
        v4u* op = (v4u*)(O + row * D + h * 128 + oq * 32);
#pragma unroll
        for (int j = 0; j < 4; ++j) { const v4u zw = zr[j]; float z[8];
            z[0] = bflo(zw.x); z[1] = bfhi(zw.x); z[2] = bflo(zw.y); z[3] = bfhi(zw.y); z[4] = bflo(zw.z); z[5] = bfhi(zw.z); z[6] = bflo(zw.w); z[7] = bfhi(zw.w);
            float y[8];
#pragma unroll
            for (int e = 0; e < 8; ++e) y[e] = ov[8 * j + e] * rn * ((const LAS float*)(lds + SCR_OFF))[oq * 32 + 8 * j + e] * siluf(z[e]);
            v4u ow; ow.x = cvtpk(y[0], y[1]); ow.y = cvtpk(y[2], y[3]); ow.z = cvtpk(y[4], y[5]); ow.w = cvtpk(y[6], y[7]);
            op[j] = ow; }
    }
    if (c < 64) {
        const v4u* zp = (const v4u*)(PROJ + (size_t)(b * SEQ + c * 64 + orow) * NPROJ + PC_Z + h * 128 + oq * 32);
#pragma unroll
        for (int j = 0; j < 4; ++j) zr[j] = zp[j];
    }
    if (c + 3 < 64) lset_load(L, gin + (size_t)(c + 3) * GDN_CH_BYTES, lt);
    if (c < 64) LBAR();
}

__device__ __forceinline__ void gdn_scan(Frame& F, int l, int bh) {
    const int b = bh >> 2, h = bh & 3;
    const int tid = F.tid, lane = F.lane, wave = F.wave, r = lane & 31, hh = lane >> 5;
    LAS unsigned char* lds = vlds(F);
    const unsigned char* gin = wsp(F) + WS_GDN + (size_t)(bh * 64) * GDN_CH_BYTES;
    __syncthreads();
    if (wave < 4) {
        const float glall = ((const float*)(wsp(F) + WS_GL))[bh * 64 + lane];
        f32x16 S0, S1, S2, S3;
#pragma unroll
        for (int i = 0; i < 16; ++i) { S0[i] = 0.f; S1[i] = 0.f; S2[i] = 0.f; S3[i] = 0.f; }
        USet UA, UB;
        uset_load(UA, gin, wave, lane); uset_load(UB, gin + (size_t)GDN_CH_BYTES, wave, lane);
        __syncthreads();
#pragma unroll 1
        for (int c = 0; c < 64; c += 2) {
            scan_step(c, UA, S0, S1, S2, S3, __shfl(glall, c), lds, gin, wave, lane, r, hh);
            scan_step(c + 1, UB, S0, S1, S2, S3, __shfl(glall, c + 1), lds, gin, wave, lane, r, hh);
        }
        __syncthreads();
        float* so = outp(F) + OSSM_P + ((size_t)(l * NB_P + b) * 4 + h) * 16384 + 32 * wave + r;
#pragma unroll
        for (int i = 0; i < 16; ++i) { so[(0 + crow(i, hh)) * 128] = S0[i]; so[(32 + crow(i, hh)) * 128] = S1[i]; so[(64 + crow(i, hh)) * 128] = S2[i]; so[(96 + crow(i, hh)) * 128] = S3[i]; }
    } else {
        const int lt = tid - 256;
        const bf16* PROJ = (const bf16*)(wsp(F) + WS_PROJ); bf16* O = (bf16*)(wsp(F) + WS_O);
        if (lt < 128) ((LAS float*)(lds + SCR_OFF))[lt] = inp(F, IN_GDNW)[l * 128 + lt];
        LSet LA, LB;
        lset_load(LA, gin, lt); lset_store(LA, lds, lt);
        lset_load(LA, gin + (size_t)GDN_CH_BYTES, lt); lset_load(LB, gin + (size_t)2 * GDN_CH_BYTES, lt);
        v4u zr[4];
#pragma unroll
        for (int j = 0; j < 4; ++j) zr[j] = (v4u){0u, 0u, 0u, 0u};
        __syncthreads();
#pragma unroll 1
        for (int c = 0; c < 64; c += 2) {
            loader_step(c, LA, zr, lds, gin, PROJ, O, b, h, lt);
            loader_step(c + 1, LB, zr, lds, gin, PROJ, O, b, h, lt);
        }
        loader_step(64, LA, zr, lds, gin, PROJ, O, b, h, lt);
        __syncthreads();
    }
}

constexpr int WL_K = 0, WL_KSTR = 144, WL_VT = 36864, WL_VSTR = 520;
static_assert(WL_VT + 64 * WL_VSTR <= SCR_OFF, "swa lds");
__device__ __forceinline__ void swa_unit(Frame& F, int l, int unit) {
    const int b = unit >> 6, qb = (unit >> 1) & 31, kvh = unit & 1;
    int tid_ = F.tid; asm volatile("" : "+v"(tid_));
    const int tid = tid_, lane = tid & 63, wave = F.wave, r = lane & 31, hh = lane >> 5;
    const bf16* PROJ = (const bf16*)(wsp(F) + WS_PROJ); bf16* O = (bf16*)(wsp(F) + WS_O);
    LAS unsigned char* lds = vlds(F);
    __syncthreads();
#pragma unroll
    for (int j = 0; j < 4; ++j) {
        const int idx = tid + 512 * j, row = idx >> 3, seg = idx & 7;
        const int s = (qb - 1) * 128 + row;
        v4u kw = (v4u){0u, 0u, 0u, 0u}, vw = kw;
        if (s >= 0) { const bf16* p = PROJ + (size_t)(b * SEQ + s) * NPROJ + kvh * 64 + seg * 8; kw = *(const v4u*)(p + PC_KB); vw = *(const v4u*)(p + PC_VB); }
        *(LAS v4u*)(lds + WL_K + row * WL_KSTR + seg * 16) = kw;
        LAS unsigned char* vt = lds + WL_VT + (seg * 8) * WL_VSTR + row * 2;
        *(LAS bf16*)(vt + 0 * WL_VSTR) = (bf16)(vw.x & 0xffffu); *(LAS bf16*)(vt + 1 * WL_VSTR) = (bf16)(vw.x >> 16);
        *(LAS bf16*)(vt + 2 * WL_VSTR) = (bf16)(vw.y & 0xffffu); *(LAS bf16*)(vt + 3 * WL_VSTR) = (bf16)(vw.y >> 16);
        *(LAS bf16*)(vt + 4 * WL_VSTR) = (bf16)(vw.z & 0xffffu); *(LAS bf16*)(vt + 5 * WL_VSTR) = (bf16)(vw.z >> 16);
        *(LAS bf16*)(vt + 6 * WL_VSTR) = (bf16)(vw.w & 0xffffu); *(LAS bf16*)(vt + 7 * WL_VSTR) = (bf16)(vw.w >> 16);
        if (qb == 31 && row >= 128) {
            float* ko = outp(F) + OK_P + ((size_t)(l * NB_P + b) * 128 + (row - 128)) * 128 + kvh * 64 + seg * 8; float* vo = outp(F) + OV_P + ((size_t)(l * NB_P + b) * 128 + (row - 128)) * 128 + kvh * 64 + seg * 8;
            *(f32x4*)ko = (f32x4){bflo(kw.x), bfhi(kw.x), bflo(kw.y), bfhi(kw.y)}; *(f32x4*)(ko + 4) = (f32x4){bflo(kw.z), bfhi(kw.z), bflo(kw.w), bfhi(kw.w)};
            *(f32x4*)vo = (f32x4){bflo(vw.x), bfhi(vw.x), bflo(vw.y), bfhi(vw.y)}; *(f32x4*)(vo + 4) = (f32x4){bflo(vw.z), bfhi(vw.z), bflo(vw.w), bfhi(vw.w)};
        }
    }
    __syncthreads();
    const int g = wave >> 1, qh = wave & 1;
    const float sink = inp(F, IN_SINKS)[l * 8 + kvh * 4 + g];
#pragma unroll 1
    for (int qa = 0; qa < 2; ++qa) {
        const int a = 2 * qh + qa;
        const int iq = 32 * a + r;
        const size_t qrow = (size_t)(b * SEQ + qb * 128 + iq);
        bf16x8 qf[4];
#pragma unroll
        for (int ks = 0; ks < 4; ++ks) qf[ks] = *(const bf16x8*)(PROJ + qrow * NPROJ + PC_QB + (kvh * 4 + g) * 64 + 16 * ks + 8 * hh);
        f32x16 P[5];
#pragma unroll
        for (int kt = 0; kt < 5; ++kt) {
#pragma unroll
            for (int i = 0; i < 16; ++i) P[kt][i] = 0.f;
#pragma unroll
            for (int ks = 0; ks < 4; ++ks) {
                const bf16x8 kf = *(const LAS bf16x8*)(lds + WL_K + (32 * (a + kt) + r) * WL_KSTR + (16 * ks + 8 * hh) * 2);
                P[kt] = MFMA32(kf, qf[ks], P[kt]);
            }
        }
        float mx = -INFINITY;
#pragma unroll
        for (int kt = 0; kt < 5; ++kt)
#pragma unroll
            for (int i = 0; i < 16; ++i) {
                const int kj = 32 * (a + kt) + crow(i, hh);
                const bool ok = (kj > iq) && (kj <= iq + 128) && (qb > 0 || kj >= 128);
                const float s = ok ? P[kt][i] * 0.125f : -INFINITY;
                P[kt][i] = s; mx = fmaxf(mx, s);
            }
        mx = fmaxf(mx, __shfl_xor(mx, 32)); mx = fmaxf(mx, sink);
        float sum = 0.f;
#pragma unroll
        for (int kt = 0; kt < 5; ++kt)
#pragma unroll
            for (int i = 0; i < 16; ++i) { const float p = __expf(P[kt][i] - mx); P[kt][i] = p; sum += p; }
        sum += __shfl_xor(sum, 32);
        const float inv = 1.0f / (sum + __expf(sink - mx));
        f32x16 o0, o1;
#pragma unroll
        for (int i = 0; i < 16; ++i) { o0[i] = 0.f; o1[i] = 0.f; }
#pragma unroll
        for (int kt = 0; kt < 5; ++kt)
#pragma unroll
            for (int s = 0; s < 2; ++s) {
                const bf16x8 pb = pack8(P[kt], s, inv);
                const int key0 = 32 * (a + kt) + 16 * s + 4 * hh;
                const LAS unsigned char* v0 = lds + WL_VT + r * WL_VSTR + key0 * 2; const LAS unsigned char* v1 = v0 + 32 * WL_VSTR;
                const v2u a0l = *(const LAS v2u*)v0, a0h = *(const LAS v2u*)(v0 + 16), a1l = *(const LAS v2u*)v1, a1h = *(const LAS v2u*)(v1 + 16);
                o0 = MFMA32(__builtin_bit_cast(bf16x8, ((v4u){a0l.x, a0l.y, a0h.x, a0h.y})), pb, o0);
                o1 = MFMA32(__builtin_bit_cast(bf16x8, ((v4u){a1l.x, a1l.y, a1h.x, a1h.y})), pb, o1);
            }
        bf16* orow = O + qrow * D + 512 + (kvh * 4 + g) * 64 + 4 * hh;
#pragma unroll
        for (int k = 0; k < 4; ++k) {
            *(v2u*)(orow + 8 * k) = (v2u){cvtpk(o0[4 * k], o0[4 * k + 1]), cvtpk(o0[4 * k + 2], o0[4 * k + 3])};
            *(v2u*)(orow + 32 + 8 * k) = (v2u){cvtpk(o1[4 * k], o1[4 * k + 1]), cvtpk(o1[4 * k + 2], o1[4 * k + 3])};
        }
    }
}

__device__ __forceinline__ void gdn_sample_round(Frame& F, int l, int item0) {
    int tid_ = F.tid; asm volatile("" : "+v"(tid_));
    const int tid = tid_, lane = tid & 63, slot = tid >> 8, v = tid & 127, kh = (tid >> 7) & 1, wsl = (tid >> 6) & 1;
    const int item = item0 + slot; const bool act = item < NB_S * 4;
    const int b = act ? item >> 2 : 0, h = item & 3;
    LAS unsigned char* lds = vlds(F);
    LAS float* sm = (LAS float*)lds + slot * 3072;
    const bf16* PROJ = (const bf16*)(wsp(F) + WS_PROJ); bf16* O = (bf16*)(wsp(F) + WS_O);
    const int row0 = MP + b * T_S;
    __syncthreads();
    float S[64];
    {   const float* S0 = inp(F, IN_SSSM) + ((size_t)(l * NB_S + b) * 4 + h) * 16384 + (size_t)(64 * kh) * 128 + v;
#pragma unroll
        for (int k = 0; k < 64; ++k) S[k] = S0[k * 128]; }
    if (kh == 0) {
        const float* cwb = inp(F, IN_CONVW) + (size_t)l * 4 * CONVCH; const float* cbuf = inp(F, IN_SCONV) + (size_t)(l * NB_S + b) * 3 * CONVCH;
        float* convout = outp(F) + OCONV_S + (size_t)(l * NB_S + b) * 3 * CONVCH;
        float yq[4], yk[4];
#pragma unroll
        for (int m = 0; m < 3; ++m) {
            const int ch = m * 512 + h * 128 + v;
            float x[7];
            x[0] = cbuf[ch]; x[1] = cbuf[CONVCH + ch]; x[2] = cbuf[2 * CONVCH + ch];
#pragma unroll
            for (int t = 0; t < 4; ++t) x[3 + t] = bf2f(PROJ[(size_t)(row0 + t) * NPROJ + ch]);
            const float c0 = cwb[ch], c1 = cwb[CONVCH + ch], c2 = cwb[2 * CONVCH + ch], c3 = cwb[3 * CONVCH + ch];
            if (act) { convout[ch] = x[4]; convout[CONVCH + ch] = x[5]; convout[2 * CONVCH + ch] = x[6]; }
#pragma unroll
            for (int t = 0; t < 4; ++t) { const float y = siluf(c0 * x[t] + c1 * x[t + 1] + c2 * x[t + 2] + c3 * x[t + 3]); sm[(m * 4 + t) * 128 + v] = y; if (m == 0) yq[t] = y; if (m == 1) yk[t] = y; }
        }
#pragma unroll
        for (int t = 0; t < 4; ++t) { const float sq = wave_sum(yq[t] * yq[t]), sk = wave_sum(yk[t] * yk[t]); if (lane == 0) { sm[1536 + wsl * 8 + t] = sq; sm[1536 + wsl * 8 + 4 + t] = sk; } }
        if (v < 4) { const bf16* prow = PROJ + (size_t)(row0 + v) * NPROJ;
            sm[1552 + v] = sigmf(bf2f(prow[PC_BLG + h])); sm[1556 + v] = __expf(-__expf(inp(F, IN_ALOG)[l * 4 + h]) * softplusf(bf2f(prow[PC_ALG + h]) + inp(F, IN_DTB)[l * 4 + h])); }
    }
    __syncthreads();
#pragma unroll 1
    for (int t = 0; t < 4; ++t) {
        const float rq = (1.0f / sqrtf(sm[1536 + t] + sm[1544 + t] + EPS)) * 0.08838834764831845f, rk = 1.0f / sqrtf(sm[1540 + t] + sm[1548 + t] + EPS);
        const float beta = sm[1552 + t], a = sm[1556 + t];
        const LAS float* kp = sm + (4 + t) * 128 + 64 * kh; const LAS float* qp = sm + t * 128 + 64 * kh;
        float dk = 0.f;
#pragma unroll
        for (int k = 0; k < 64; ++k) { S[k] *= a; dk += S[k] * kp[k]; if ((k & 15) == 15) asm volatile("" ::: "memory"); }
        sm[2048 + kh * 128 + v] = dk;
        __syncthreads();
        const float coef = beta * (sm[(8 + t) * 128 + v] - (sm[2048 + v] + sm[2176 + v]) * rk) * rk;
        float o = 0.f;
#pragma unroll
        for (int k = 0; k < 64; ++k) { S[k] += kp[k] * coef; o += S[k] * qp[k]; if ((k & 15) == 15) asm volatile("" ::: "memory"); }
        __syncthreads();
        sm[2048 + kh * 128 + v] = o;
        __syncthreads();
        if (kh == 0) { const float ot = (sm[2048 + v] + sm[2176 + v]) * rq; sm[2304 + t * 128 + v] = ot; const float ss = wave_sum(ot * ot); if (lane == 0) sm[1568 + wsl * 4 + t] = ss; }
        __syncthreads();
    }
    if (act) { float* So = outp(F) + OSSM_S + ((size_t)(l * NB_S + b) * 4 + h) * 16384 + (size_t)(64 * kh) * 128 + v;
#pragma unroll
        for (int k = 0; k < 64; ++k) So[k * 128] = S[k]; }
    if (act && kh == 0) {
        const float gw = inp(F, IN_GDNW)[l * 128 + v];
#pragma unroll
        for (int t = 0; t < 4; ++t) {
            const float rn = 1.0f / sqrtf((sm[1568 + t] + sm[1572 + t]) * (1.f / 128.f) + EPS);
            const float z = bf2f(PROJ[(size_t)(row0 + t) * NPROJ + PC_Z + h * 128 + v]);
            O[(size_t)(row0 + t) * D + h * 128 + v] = (bf16)f2bf(sm[2304 + t * 128 + v] * rn * gw * siluf(z));
        }
    }
}

__device__ __forceinline__ void swa_sample_item(Frame& F, int l, int item) {
    int tid_ = F.tid; asm volatile("" : "+v"(tid_));
    const int lane = tid_ & 63, wave = F.wave;
    const int b = item >> 1, kvh = item & 1;
    LAS unsigned char* lds = vlds(F);
    LAS float* qs = (LAS float*)lds + wave * 3200;
    LAS float* ps = qs + 1024;
    const bf16* PROJ = (const bf16*)(wsp(F) + WS_PROJ); bf16* O = (bf16*)(wsp(F) + WS_O);
    const int row0 = MP + b * T_S;
    const float* ck = inp(F, IN_CK) + ((size_t)(l * NB_S + b) * 128) * 128 + kvh * 64;
    const float* cv = inp(F, IN_CV) + ((size_t)(l * NB_S + b) * 128) * 128 + kvh * 64;
    float* ko = outp(F) + OK_S + ((size_t)(l * NB_S + b) * 128) * 128 + kvh * 64;
    float* vo = outp(F) + OV_S + ((size_t)(l * NB_S + b) * 128) * 128 + kvh * 64;
#pragma unroll
    for (int qr = 0; qr < 16; ++qr) qs[qr * 64 + lane] = bf2f(PROJ[(size_t)(row0 + (qr & 3)) * NPROJ + PC_QB + (kvh * 4 + (qr >> 2)) * 64 + lane]);
    LDS_WAIT(); asm volatile("" ::: "memory");
#pragma unroll 1
    for (int p = 0; p < 3; ++p) {
        const int cidx = lane + 64 * p;
        if (cidx < 132) {
            float kreg[64];
            if (cidx < 128) {
                const f32x4* kp = (const f32x4*)(ck + (size_t)cidx * 128);
#pragma unroll
                for (int d4 = 0; d4 < 16; ++d4) { const f32x4 w = kp[d4]; kreg[4 * d4] = w.x; kreg[4 * d4 + 1] = w.y; kreg[4 * d4 + 2] = w.z; kreg[4 * d4 + 3] = w.w; }
            } else {
                const v4u* kp = (const v4u*)(PROJ + (size_t)(row0 + cidx - 128) * NPROJ + PC_KB + kvh * 64);
#pragma unroll
                for (int d8 = 0; d8 < 8; ++d8) { const v4u w = kp[d8];
                    kreg[8 * d8 + 0] = bflo(w.x); kreg[8 * d8 + 1] = bfhi(w.x); kreg[8 * d8 + 2] = bflo(w.y); kreg[8 * d8 + 3] = bfhi(w.y);
                    kreg[8 * d8 + 4] = bflo(w.z); kreg[8 * d8 + 5] = bfhi(w.z); kreg[8 * d8 + 6] = bflo(w.w); kreg[8 * d8 + 7] = bfhi(w.w); }
            }
            if (cidx >= 4) { f32x4* kd = (f32x4*)(ko + (size_t)(cidx - 4) * 128);
#pragma unroll
                for (int d4 = 0; d4 < 16; ++d4) kd[d4] = (f32x4){kreg[4 * d4], kreg[4 * d4 + 1], kreg[4 * d4 + 2], kreg[4 * d4 + 3]}; }
#pragma unroll 1
            for (int qr = 0; qr < 16; ++qr) {
                float s = 0.f;
#pragma unroll
                for (int d4 = 0; d4 < 16; ++d4) { const f32x4 qv = *(const LAS f32x4*)(qs + qr * 64 + 4 * d4); s += kreg[4 * d4] * qv.x + kreg[4 * d4 + 1] * qv.y + kreg[4 * d4 + 2] * qv.z + kreg[4 * d4 + 3] * qv.w; }
                ps[cidx * 16 + qr] = s * 0.125f;
            }
        }
    }
    LDS_WAIT(); asm volatile("" ::: "memory");
#pragma unroll 1
    for (int qr = 0; qr < 16; ++qr) {
        const int t = qr & 3; const float sk = inp(F, IN_SINKS)[l * 8 + kvh * 4 + (qr >> 2)];
        float s[3]; float mx = sk;
#pragma unroll
        for (int p = 0; p < 3; ++p) { const int cidx = lane + 64 * p; const bool ok = cidx < 132 && cidx > t && cidx <= t + 128; s[p] = ok ? ps[cidx * 16 + qr] : -INFINITY; mx = fmaxf(mx, s[p]); }
        mx = wave_max(mx);
        float sum = 0.f;
#pragma unroll
        for (int p = 0; p < 3; ++p) { s[p] = __expf(s[p] - mx); sum += s[p]; }
        sum = wave_sum(sum) + __expf(sk - mx);
        const float inv = 1.0f / sum;
#pragma unroll
        for (int p = 0; p < 3; ++p) { const int cidx = lane + 64 * p; if (cidx < 132) ps[cidx * 16 + qr] = s[p] * inv; }
    }
    LDS_WAIT(); asm volatile("" ::: "memory");
    float acc[16];
#pragma unroll
    for (int qr = 0; qr < 16; ++qr) acc[qr] = 0.f;
#pragma unroll 1
    for (int c0 = 0; c0 < 132; c0 += 12) {
        float vv[12];
#pragma unroll
        for (int j = 0; j < 12; ++j) { const int cidx = c0 + j; vv[j] = cidx < 128 ? cv[(size_t)cidx * 128 + lane] : bf2f(PROJ[(size_t)(row0 + cidx - 128) * NPROJ + PC_VB + kvh * 64 + lane]); }
#pragma unroll
        for (int j = 0; j < 12; ++j) { const int cidx = c0 + j;
            if (cidx >= 4) vo[(size_t)(cidx - 4) * 128 + lane] = vv[j];
#pragma unroll
            for (int q4 = 0; q4 < 4; ++q4) { const f32x4 pv = *(const LAS f32x4*)(ps + cidx * 16 + 4 * q4);
                acc[4 * q4] += pv.x * vv[j]; acc[4 * q4 + 1] += pv.y * vv[j]; acc[4 * q4 + 2] += pv.z * vv[j]; acc[4 * q4 + 3] += pv.w * vv[j]; } }
    }
#pragma unroll
    for (int qr = 0; qr < 16; ++qr) O[(size_t)(row0 + (qr & 3)) * D + 512 + (kvh * 4 + (qr >> 2)) * 64 + lane] = (bf16)f2bf(acc[qr]);
    LDS_WAIT(); asm volatile("" ::: "memory");
}

__device__ __forceinline__ void mixers_rest(Frame& F, int l) {
    const int wg = F.bid - 16, nwg = F.G - 16;
    const int n_swa_wg = (NB_S * 2) / NWAVES;
    for (int rr = wg; rr < n_swa_wg + NB_S * 2; rr += nwg) {
        if (rr < NB_S * 2) gdn_sample_round(F, l, rr * 2);
        else { swa_sample_item(F, l, (rr - NB_S * 2) * NWAVES + F.wave); __syncthreads(); }
    }
}

struct Args { const float* in[23]; float* out; unsigned char* ws; int ph_lo, ph_hi; };
constexpr int NPH = 3 + 8 * DEPTH;

__global__ void __launch_bounds__(NTHR, 2) mega_fwd(Args args) {
    extern __shared__ __attribute__((aligned(16))) unsigned char lds[];
    Frame F;
    F.lds = (LAS unsigned char*)lds;
    F.tid = threadIdx.x; F.lane = F.tid & 63; F.wave = __builtin_amdgcn_readfirstlane(F.tid >> 6);
    F.G = gridDim.x; F.bid = blockIdx.x;
    if (F.tid < 23) ((LAS unsigned long long*)(F.lds + TAB_OFF))[F.tid] = (unsigned long long)args.in[F.tid];
    F.out = args.out; F.ws = args.ws;
    __syncthreads();
#if MK_ONE_LAUNCH
    cooperative_groups::grid_group grid = cooperative_groups::this_grid();
    volatile LAS unsigned* MISC = (volatile LAS unsigned*)(F.lds + MISC_OFF);
    if (F.tid < 32) MISC[F.tid] = 0u;
    __syncthreads();
    XcdBarrier bar = xcd_barrier_post((unsigned*)(args.ws + WS_CTL) + CW_BAR, MISC + 8);
#endif
    int rep_ = 0;
    for (int ph = args.ph_lo; ph < args.ph_hi;) {
        { int t_ = threadIdx.x; asm volatile("" : "+v"(t_)); F.tid = t_; F.lane = t_ & 63; F.wave = __builtin_amdgcn_readfirstlane(t_ >> 6);
          int b_ = blockIdx.x, g_ = gridDim.x; asm volatile("" : "+s"(b_), "+s"(g_)); F.bid = b_; F.G = g_; }
        int kind, l = 0;
        if (ph < 3) kind = ph; else { l = (ph - 3) / 8; kind = 3 + (ph - 3) % 8; }
        if (kind == 0) p0_prologue(F);
        else if (kind == 2) rowpass0(F);
        else if (kind == 4) { for (int u = F.bid; u < 1024 + 256; u += F.G) { if (u < 1024) gdn_prep_unit(F, l, u); else swa_unit(F, l, u - 1024); } }
        else if (kind == 5) { if (F.bid < 16) gdn_scan(F, l, F.bid); else mixers_rest(F, l); }
        else if (kind == 7) rowpass12(F, l, 1);
        else if (kind == 10) rowpass12(F, l, 2);
        else if (kind == 3) {
            pg8::Gemm g{(const bf16*)(wsp(F) + WS_XN), (const bf16*)(wsp(F) + WS_WIN) + (size_t)l * NPROJ * D, M, NPROJ, D};
            pg8::StaticOrder S; S.init(M, NPROJ, F.G, F.bid);
            pg8::EpiBf16<0> E{(bf16*)(wsp(F) + WS_PROJ), NPROJ};
            pg8::gemm_phase<pg8::EpiBf16<0>, pg8::StaticOrder, PG8_ALIGN, PG8_SP2>(F.lds + RING_OFF, g, S, E, F.tid);
        } else if (kind == 8) {
            pg8::Gemm g{(const bf16*)(wsp(F) + WS_XN), (const bf16*)(wsp(F) + WS_WUP) + (size_t)l * FF * D, M, FF, D};
            pg8::StaticOrder S; S.init(M, FF, F.G, F.bid);
            pg8::EpiBf16<2> E{(bf16*)(wsp(F) + WS_H), FF};
            pg8::gemm_phase<pg8::EpiBf16<2>, pg8::StaticOrder, PG8_ALIGN, PG8_SP2>(F.lds + RING_OFF, g, S, E, F.tid);
        } else {
            pg8::Gemm g; pg8::EpiF32 E;
            if (kind == 1) { g = pg8::Gemm{(const bf16*)(wsp(F) + WS_SC), (const bf16*)(wsp(F) + WS_WADA), 256, DEPTH * NMOD, D}; E = pg8::EpiF32{(float*)(wsp(F) + WS_MOD), DEPTH * NMOD, inp(F, IN_BADA)}; }
            else if (kind == 6) { g = pg8::Gemm{(const bf16*)(wsp(F) + WS_O), (const bf16*)(wsp(F) + WS_WO) + (size_t)l * D * D, M, D, D}; E = pg8::EpiF32{(float*)(wsp(F) + WS_MIX), D, nullptr}; }
            else { g = pg8::Gemm{(const bf16*)(wsp(F) + WS_H), (const bf16*)(wsp(F) + WS_WDN) + (size_t)l * D * FF, M, D, FF}; E = pg8::EpiF32{(float*)(wsp(F) + WS_MIX), D, nullptr}; }
            pg8::StaticOrder S; S.init(g.M, g.N, F.G, F.bid);
            pg8::gemm_phase<pg8::EpiF32, pg8::StaticOrder, PG8_ALIGN, PG8_SP2>(F.lds + RING_OFF, g, S, E, F.tid);
        }
#if MK_ONE_LAUNCH
        const bool again_ = (kind == DUP_KIND && rep_ == 0);
        if (ph + 1 < args.ph_hi || again_) { if (ph == args.ph_lo && rep_ == 0) grid.sync(); else xcd_barrier(bar); }
#else
        const bool again_ = false;
#endif
        if (again_) rep_ = 1; else { rep_ = 0; ++ph; }
    }
}

extern "C" void kernel_launch(void* const* d_in, const int* in_sizes, int n_in, void* d_out, int out_size, void* d_ws, size_t ws_size, hipStream_t stream) {
    static int grid = 0;
    if (grid == 0) {
        if (n_in != 23 || (size_t)out_size != OUT_TOTAL || ws_size < WS_END) { fprintf(stderr, "kernel_launch: unexpected shapes n_in %d out %d ws %zu\n", n_in, out_size, ws_size); grid = -1; return; }
        int dev = 0, cus = 0, per_cu = 0;
        if (hipGetDevice(&dev) != hipSuccess || hipDeviceGetAttribute(&cus, hipDeviceAttributeMultiprocessorCount, dev) != hipSuccess) { grid = -1; return; }
        if (hipFuncSetAttribute((const void*)mega_fwd, hipFuncAttributeMaxDynamicSharedMemorySize, LDS_BYTES) != hipSuccess) { fprintf(stderr, "kernel_launch: hipFuncSetAttribute failed\n"); grid = -1; return; }
        if (hipOccupancyMaxActiveBlocksPerMultiprocessor(&per_cu, (const void*)mega_fwd, NTHR, LDS_BYTES) != hipSuccess || per_cu < 1) { fprintf(stderr, "kernel_launch: occupancy query says %d\n", per_cu); per_cu = 1; }
        (void)hipGetLastError();
        grid = cus;
    }
    if (grid < 0) return;
    if (hipMemsetAsync((char*)d_ws + WS_CTL, 0, CTL_ZERO_BYTES, stream) != hipSuccess) { fprintf(stderr, "kernel_launch: memset failed\n"); return; }
    Args a{};
    for (int i = 0; i < 23; ++i) a.in[i] = (const float*)d_in[i];
    a.out = (float*)d_out; a.ws = (unsigned char*)d_ws;
#if MK_ONE_LAUNCH
    a.ph_lo = 0; a.ph_hi = NPH;
    void* kargs[] = {&a};
    hipError_t e = hipLaunchCooperativeKernel((const void*)mega_fwd, dim3(grid), dim3(NTHR), kargs, LDS_BYTES, stream);
    if (e != hipSuccess) fprintf(stderr, "cooperative launch failed: %s (grid %d)\n", hipGetErrorString(e), grid);
#else
    for (int ph = 0; ph < NPH; ++ph) {
        a.ph_lo = ph; a.ph_hi = ph + 1;
        hipLaunchKernelGGL(mega_fwd, dim3(grid), dim3(NTHR), LDS_BYTES, stream, a);
    }
#endif
}
```
